# Optimizing an MI355X kernel written in HIP

```python
import jax, jax.numpy as jnp
from jax import lax
import numpy as np

D_MODEL = 2048
BATCH = 1
SEQ = 8192
DEPTH = 2

N_MIXERS = 2
N_FOX_LAYERS = (DEPTH + 1) // 2
N_GLA_LAYERS = DEPTH // 2
FOX_HEADS = 16
FOX_HEAD_DIM = D_MODEL // FOX_HEADS
Q_BLOCK = 128
FOX_BIAS_OFFSET = 4.0
GLA_HEADS = 4
GLA_DK = D_MODEL // 2
GLA_DV = D_MODEL
GLA_DK_HEAD = GLA_DK // GLA_HEADS
GLA_DV_HEAD = GLA_DV // GLA_HEADS
GLA_GATE_RANK = 16
GLA_GATE_TAU = 16.0
GLA_CHUNK = 64
N_GROUPS = 8
EXPERTS_PER_GROUP = 8
N_EXPERTS = N_GROUPS * EXPERTS_PER_GROUP
TOP_K_INNER = 2
EXPERT_FF = D_MODEL // 4
MOE_BLOCK = 128
DEEPNORM_ALPHA = (2 * DEPTH) ** 0.25
DEEPNORM_BETA = (8 * DEPTH) ** -0.25
LN_EPS = 1e-5
RMS_EPS = 1e-6

kernel_name = "hybrid_fox_gla_hier_moe_deepnorm"


def layer_norm(x, g, b):
    xf = x.astype(jnp.float32)
    mu = jnp.mean(xf, axis=-1, keepdims=True)
    var = jnp.mean(jnp.square(xf - mu), axis=-1, keepdims=True)
    return ((xf - mu) * lax.rsqrt(var + LN_EPS) * g + b).astype(x.dtype)


def fox_mixer(x, w_in, b_f, w_o):
    B, S, D = x.shape
    H, Dh = FOX_HEADS, FOX_HEAD_DIM
    proj = x @ w_in
    q = proj[..., :D].reshape(B, S, H, Dh).transpose(0, 2, 1, 3)
    k = proj[..., D:2 * D].reshape(B, S, H, Dh).transpose(0, 2, 1, 3)
    v = proj[..., 2 * D:3 * D].reshape(B, S, H, Dh).transpose(0, 2, 1, 3)
    log_f = jax.nn.log_sigmoid((proj[..., 3 * D:] + b_f).astype(jnp.float32))
    c = jnp.cumsum(log_f, axis=1).transpose(0, 2, 1)
    n_blk = S // Q_BLOCK
    q_blocks = q.reshape(B, H, n_blk, Q_BLOCK, Dh).transpose(2, 0, 1, 3, 4)
    c_q = c.reshape(B, H, n_blk, Q_BLOCK).transpose(2, 0, 1, 3)
    key_pos = jnp.arange(S)
    scale = FOX_HEAD_DIM ** -0.5

    def attend(args):
        blk, qb, cq = args
        q_pos = blk * Q_BLOCK + jnp.arange(Q_BLOCK)
        s = jnp.einsum('bhqd,bhkd->bhqk', qb, k).astype(jnp.float32) * scale
        s = s + (cq[..., :, None] - c[..., None, :])
        s = jnp.where(key_pos[None, :] <= q_pos[:, None], s, -jnp.inf)
        p = jax.nn.softmax(s, axis=-1).astype(v.dtype)
        return jnp.einsum('bhqk,bhkd->bhqd', p, v)

    o = lax.map(attend, (jnp.arange(n_blk), q_blocks, c_q))
    o = o.transpose(1, 0, 3, 2, 4).reshape(B, S, D)
    return o @ w_o


def gla_mixer(x, w_in, w_gate_up, b_gate, norm_g, w_o):
    B, S, D = x.shape
    H, dk, dv, C = GLA_HEADS, GLA_DK_HEAD, GLA_DV_HEAD, GLA_CHUNK
    N = S // C
    proj = x @ w_in
    o1, o2, o3, o4 = GLA_DK, 2 * GLA_DK, 2 * GLA_DK + GLA_DV, 2 * GLA_DK + 2 * GLA_DV
    q, k, v, r, g_low = proj[..., :o1], proj[..., o1:o2], proj[..., o2:o3], proj[..., o3:o4], proj[..., o4:]
    log_alpha = jax.nn.log_sigmoid((g_low @ w_gate_up + b_gate).astype(jnp.float32)) / GLA_GATE_TAU

    def heads_chunks(t, dh):
        return t.astype(jnp.float32).reshape(B, N, C, H, dh).transpose(0, 3, 1, 2, 4)

    qf = heads_chunks(q, dk) * (dk ** -0.5)
    kf = heads_chunks(k, dk)
    vf = heads_chunks(v, dv)
    b = jnp.cumsum(heads_chunks(log_alpha, dk), axis=3)
    b_ref = b[:, :, :, C // 2 - 1:C // 2, :]
    a = jnp.einsum('bhncd,bhnjd->bhncj', qf * jnp.exp(b - b_ref), kf * jnp.exp(b_ref - b))
    causal = jnp.tril(jnp.ones((C, C), dtype=bool))
    a = jnp.where(causal, a, 0.0)
    o_intra = jnp.einsum('bhncj,bhnjv->bhncv', a, vf)
    b_last = b[:, :, :, -1, :]
    q_inter = qf * jnp.exp(b)
    k_end = kf * jnp.exp(b_last[:, :, :, None, :] - b)

    def step(state, inp):
        qi, ki, vi, bl = inp
        out = jnp.einsum('bhcd,bhdv->bhcv', qi, state)
        state = jnp.exp(bl)[..., None] * state + jnp.einsum('bhcd,bhcv->bhdv', ki, vi)
        return state, out

    xs = (jnp.moveaxis(q_inter, 2, 0), jnp.moveaxis(k_end, 2, 0), jnp.moveaxis(vf, 2, 0), jnp.moveaxis(b_last, 2, 0))
    _, o_inter = lax.scan(step, jnp.zeros((B, H, dk, dv), jnp.float32), xs)
    o = o_intra + jnp.moveaxis(o_inter, 0, 2)
    o = o.transpose(0, 2, 3, 1, 4).reshape(B, S, H, dv)
    o = o * lax.rsqrt(jnp.mean(jnp.square(o), axis=-1, keepdims=True) + RMS_EPS) * norm_g
    o = o.reshape(B, S, GLA_DV).astype(x.dtype) * jax.nn.silu(r)
    return o @ w_o


def hier_moe(x, w_group, b_group, w_expert, b_expert, w_gate, w_up, w_down):
    B, S, D = x.shape
    T = B * S
    K = TOP_K_INNER
    xt = x.reshape(T, D)
    grp_prob = jax.nn.softmax((xt @ w_group + b_group).astype(jnp.float32), axis=-1)
    grp_p, grp_idx = lax.top_k(grp_prob, 1)
    exp_logits = (xt @ w_expert + b_expert).astype(jnp.float32).reshape(T, N_GROUPS, EXPERTS_PER_GROUP)
    exp_logits = jnp.take_along_axis(exp_logits, grp_idx[:, :, None], axis=1)[:, 0]
    in_p, in_idx = lax.top_k(jax.nn.softmax(exp_logits, axis=-1), K)
    in_p = in_p / jnp.sum(in_p, axis=-1, keepdims=True)
    gates = grp_p * in_p
    expert_id = grp_idx * EXPERTS_PER_GROUP + in_idx
    A = T * K
    flat_e = expert_id.reshape(A).astype(jnp.int32)
    flat_tok = jnp.broadcast_to(jnp.arange(T, dtype=jnp.int32)[:, None], (T, K)).reshape(A)
    flat_gate = gates.reshape(A)
    order = jnp.argsort(flat_e)
    sorted_e = flat_e[order]
    counts = jnp.zeros((N_EXPERTS,), jnp.int32).at[flat_e].add(1)
    start = jnp.cumsum(counts) - counts
    padded = ((counts + MOE_BLOCK - 1) // MOE_BLOCK) * MOE_BLOCK
    pad_end = jnp.cumsum(padded)
    pad_start = pad_end - padded
    dest = pad_start[sorted_e] + (jnp.arange(A, dtype=jnp.int32) - start[sorted_e])
    P = ((A + MOE_BLOCK - 1) // MOE_BLOCK) * MOE_BLOCK + N_EXPERTS * MOE_BLOCK
    slot_tok = jnp.zeros((P,), jnp.int32).at[dest].set(flat_tok[order])
    slot_gate = jnp.zeros((P,), x.dtype).at[dest].set(flat_gate[order].astype(x.dtype))
    n_blocks = P // MOE_BLOCK
    blk_start = jnp.arange(n_blocks, dtype=jnp.int32) * MOE_BLOCK
    blk_expert = jnp.minimum(jnp.searchsorted(pad_end, blk_start, side='right'), N_EXPERTS - 1)

    def run_block(args):
        e, toks = args
        xb = xt[toks]
        h = jax.nn.silu(xb @ w_gate[e]) * (xb @ w_up[e])
        return h @ w_down[e]

    y = lax.map(run_block, (blk_expert, slot_tok.reshape(n_blocks, MOE_BLOCK)))
    y = y.reshape(P, D) * slot_gate[:, None]
    out = jnp.zeros((T, D), x.dtype).at[slot_tok].add(y)
    return out.reshape(B, S, D)


def setup_inputs(seed: int = 0) -> dict:
    key = jax.random.key(seed)
    ks = jax.random.split(key, 24)
    f32 = jnp.float32

    def nrm(k, shape, scale):
        return jax.random.normal(k, shape, f32) * scale

    D = D_MODEL
    x = jax.random.normal(ks[0], (BATCH, SEQ, D), f32)
    fox_w_in = nrm(ks[1], (N_FOX_LAYERS, D, 3 * D + FOX_HEADS), D ** -0.5)
    fox_w_in = fox_w_in.at[:, :, 2 * D:3 * D].multiply(DEEPNORM_BETA)
    fox_b_f = FOX_BIAS_OFFSET + nrm(ks[2], (N_FOX_LAYERS, FOX_HEADS), 0.5)
    fox_w_o = nrm(ks[3], (N_FOX_LAYERS, D, D), D ** -0.5 * DEEPNORM_BETA)
    gla_w_in = nrm(ks[4], (N_GLA_LAYERS, D, 2 * GLA_DK + 2 * GLA_DV + GLA_GATE_RANK), D ** -0.5)
    gla_w_in = gla_w_in.at[:, :, 2 * GLA_DK:2 * GLA_DK + GLA_DV].multiply(DEEPNORM_BETA)
    gla_w_gate_up = nrm(ks[5], (N_GLA_LAYERS, GLA_GATE_RANK, GLA_DK), GLA_GATE_RANK ** -0.5)
    gla_b_gate = nrm(ks[6], (N_GLA_LAYERS, GLA_DK), 0.1)
    gla_norm_g = 1.0 + nrm(ks[7], (N_GLA_LAYERS, GLA_DV_HEAD), 0.01)
    gla_w_o = nrm(ks[8], (N_GLA_LAYERS, GLA_DV, D), GLA_DV ** -0.5 * DEEPNORM_BETA)
    ln_mix_g = 1.0 + nrm(ks[9], (DEPTH, D), 0.01)
    ln_mix_b = nrm(ks[10], (DEPTH, D), 0.01)
    ln_ffn_g = 1.0 + nrm(ks[11], (DEPTH, D), 0.01)
    ln_ffn_b = nrm(ks[12], (DEPTH, D), 0.01)
    moe_w_group = nrm(ks[13], (DEPTH, D, N_GROUPS), D ** -0.5)
    moe_b_group = nrm(ks[14], (DEPTH, N_GROUPS), 0.01)
    moe_w_expert = nrm(ks[15], (DEPTH, D, N_EXPERTS), D ** -0.5)
    moe_b_expert = nrm(ks[16], (DEPTH, N_EXPERTS), 0.01)
    moe_w_gate = nrm(ks[17], (DEPTH, N_EXPERTS, D, EXPERT_FF), D ** -0.5)
    moe_w_up = nrm(ks[18], (DEPTH, N_EXPERTS, D, EXPERT_FF), D ** -0.5)
    moe_w_down = nrm(ks[19], (DEPTH, N_EXPERTS, EXPERT_FF, D), EXPERT_FF ** -0.5 * DEEPNORM_BETA)
    return {"x": x, "fox_w_in": fox_w_in, "fox_b_f": fox_b_f, "fox_w_o": fox_w_o,
            "gla_w_in": gla_w_in, "gla_w_gate_up": gla_w_gate_up, "gla_b_gate": gla_b_gate,
            "gla_norm_g": gla_norm_g, "gla_w_o": gla_w_o,
            "ln_mix_g": ln_mix_g, "ln_mix_b": ln_mix_b, "ln_ffn_g": ln_ffn_g, "ln_ffn_b": ln_ffn_b,
            "moe_w_group": moe_w_group, "moe_b_group": moe_b_group,
            "moe_w_expert": moe_w_expert, "moe_b_expert": moe_b_expert,
            "moe_w_gate": moe_w_gate, "moe_w_up": moe_w_up, "moe_w_down": moe_w_down}


def reference(x, fox_w_in, fox_b_f, fox_w_o, gla_w_in, gla_w_gate_up, gla_b_gate, gla_norm_g, gla_w_o,
              ln_mix_g, ln_mix_b, ln_ffn_g, ln_ffn_b, moe_w_group, moe_b_group, moe_w_expert,
              moe_b_expert, moe_w_gate, moe_w_up, moe_w_down):
    for i in range(DEPTH):
        j = i // N_MIXERS
        if i % N_MIXERS == 0:
            mix = fox_mixer(x, fox_w_in[j], fox_b_f[j], fox_w_o[j])
        else:
            mix = gla_mixer(x, gla_w_in[j], gla_w_gate_up[j], gla_b_gate[j], gla_norm_g[j], gla_w_o[j])
        x = layer_norm(DEEPNORM_ALPHA * x + mix, ln_mix_g[i], ln_mix_b[i])
        ffn = hier_moe(x, moe_w_group[i], moe_b_group[i], moe_w_expert[i], moe_b_expert[i],
                       moe_w_gate[i], moe_w_up[i], moe_w_down[i])
        x = layer_norm(DEEPNORM_ALPHA * x + ffn, ln_ffn_g[i], ln_ffn_b[i])
    return x
```

```cpp
#ifndef DBL_MASK
#define DBL_MASK 0x0
#endif
#include <hip/hip_runtime.h>
#include <cstdio>
#include <cstdint>

constexpr int T = 8192, DM = 2048, NQKV = 6144, NPROJ = 6160;
constexpr int FOX_H = 16, FOX_DH = 128;
constexpr int GLA_H = 4, GLA_DK = 256, GLA_DV = 512, GLA_C = 64, GLA_NCH = T / GLA_C;
constexpr int NEXP = 64, EFF = 512;
constexpr float ALPHA = 1.4142135623730951f;
constexpr float LN_EPS = 1e-5f, RMS_EPS = 1e-6f;
constexpr float FOX_SCALE = 0.08838834764831845f;

typedef unsigned short bf16;

constexpr size_t MiB = 1u << 20;
constexpr size_t WS_CTL = 0, CTL_ZERO_BYTES = 1 * MiB;
constexpr size_t WS_XB = 2 * MiB;
constexpr size_t WS_QKV = 34 * MiB;
constexpr size_t WS_FLOG = 130 * MiB;
constexpr size_t WS_CB = 131 * MiB;
constexpr size_t WS_O = 132 * MiB;
constexpr size_t WS_Y = 164 * MiB;
constexpr size_t WS_XF = 228 * MiB;
constexpr size_t WS_XF2 = 292 * MiB;
constexpr size_t WS_TOPE = 356 * MiB;
constexpr size_t WS_TOPG = 357 * MiB;
constexpr size_t WS_LIST = 358 * MiB;
constexpr size_t WS_HID = 360 * MiB;
constexpr size_t WS_YE = 378 * MiB;
constexpr size_t WS_WT = 442 * MiB;
constexpr size_t WS_WR = 506 * MiB;
constexpr size_t WS_GLA = 508 * MiB;
constexpr size_t WS_LA = WS_GLA;
constexpr size_t WS_OR = WS_GLA + 32 * MiB;
constexpr size_t WS_GQT = WS_GLA + 96 * MiB, WS_GKT = WS_GLA + 112 * MiB, WS_GQI = WS_GLA + 128 * MiB;
constexpr size_t WS_GKET = WS_GLA + 144 * MiB;
constexpr size_t WS_GVT = WS_GLA + 160 * MiB;
constexpr size_t WS_GDL = WS_GLA + 192 * MiB;
constexpr size_t WS_GOI = WS_GLA + 193 * MiB;
constexpr size_t WS_GSE = WS_GLA + 258 * MiB;
constexpr size_t WS_GPE = WS_GLA + 274 * MiB;
constexpr size_t WS_GOI2 = WS_GLA + 275 * MiB;
constexpr size_t WS_END = WS_GLA + 342 * MiB;
constexpr int CW_CNT = 1024;
constexpr int CW_MOEF = 65536;

__device__ __forceinline__ unsigned f2bf(float f) { unsigned u = __builtin_bit_cast(unsigned, f); return (u + 0x7fffu + ((u >> 16) & 1u)) >> 16; }
__device__ __forceinline__ float bf2f(bf16 b) { return __builtin_bit_cast(float, (unsigned)b << 16); }
__device__ __forceinline__ float bfr(float f) { return bf2f((bf16)f2bf(f)); }
__device__ __forceinline__ float log_sigmoid(float z) { return fminf(z, 0.f) - __logf(1.f + __expf(-fabsf(z))); }
__device__ __forceinline__ float silu(float z) { return z * __builtin_amdgcn_rcpf(1.f + __expf(-z)); }

namespace pg8 {
#define PG8_LAS __attribute__((address_space(3)))
typedef unsigned short bf16_t;
typedef short bf16x8 __attribute__((ext_vector_type(8)));
typedef float f32x4 __attribute__((ext_vector_type(4)));
typedef unsigned u32x4 __attribute__((ext_vector_type(4)));
constexpr int BM = 256, BK = 64, HALF = 128, HTB = HALF * BK * 2  , STAGE_BYTES = 8 * HTB, NXCD = 8, WGM = 8;

__host__ __device__ __forceinline__ int lds_byte(int r, int c) { const int st = (r >> 4) * 2 + (c >> 5), rr = r & 15, cc = c & 31, ob = rr * 64 + cc * 2; return st * 1024 + (ob ^ (((ob >> 9) & 1) << 5)); }
__host__ __device__ __forceinline__ void stage_rc(int b, int& R, int& C) { const int st = b / 1024, sb = b % 1024, swz = sb ^ (((sb >> 9) & 1) << 5); R = (st >> 1) * 16 + swz / 64; C = (st & 1) * 32 + (swz % 64) / 2; }
__host__ __device__ __forceinline__ int perm32(int rho) { const int n = rho >> 4, i = rho & 15; return 8 * (i >> 2) + 4 * n + (i & 3); }

struct Unit { int pm, pn; };
struct Gemm { const bf16_t* A; const bf16_t* Bt; int M, N, K; };

struct StaticOrder {
    int nM, nN, nwg, G, c;
    __host__ __device__ void init(int M, int N, int G_, int c_) { nM = M / BM; nN = N / BM; nwg = nM * nN; G = G_; c = c_; }
    __host__ __device__ bool next(int i, Unit& u) const {
        const long L = (long)i * G + c; if (L >= nwg) return false;
        int wgid = (int)L; { const int q = nwg / NXCD, r = nwg % NXCD, xcd = wgid % NXCD, off = wgid / NXCD; wgid = (xcd < r ? xcd * (q + 1) : r * (q + 1) + (xcd - r) * q) + off; }
        const int nig = WGM * nN, gid = wgid / nig, fm = gid * WGM, gsz = (nM - fm) < WGM ? (nM - fm) : WGM;
        u.pm = fm + ((wgid % nig) % gsz); u.pn = (wgid % nig) / gsz; return true;
    }
    __device__ __forceinline__ void a_ready(const Unit&) const {}
    __device__ __forceinline__ void done(const Unit&) const {}
};

__device__ __forceinline__ unsigned cvt_pk_bf16(float lo, float hi) { unsigned r; asm volatile("v_cvt_pk_bf16_f32 %0, %1, %2" : "=v"(r) : "v"(lo), "v"(hi)); return r; }
typedef float f32x2 __attribute__((ext_vector_type(2)));
__device__ __forceinline__ f32x2 gelu_pk(f32x2 v) {
    const f32x2 av = __builtin_elementwise_abs(v), d = av * 0.2316418882f + 1.0f;
    f32x2 t; t.x = __builtin_amdgcn_rcpf(d.x); t.y = __builtin_amdgcn_rcpf(d.y);
    f32x2 q = t * 0.5307027145f + (-0.7265760135f); q = q * t + 0.7107068705f; q = q * t + (-0.142248368f); q = q * t + 0.127414796f; q = q * t;
    const f32x2 s = (v * v) * (-0.72134752044f);
    f32x2 e; e.x = __builtin_amdgcn_exp2f(s.x); e.y = __builtin_amdgcn_exp2f(s.y);
    const f32x2 m = v * (q * e), r = v - m;
    f32x2 o; o.x = v.x < 0.f ? m.x : r.x; o.y = v.y < 0.f ? m.y : r.y; return o;
}

template <int ACT  > struct EpiBf16 {
    static constexpr bool PERM = true, AFTER_DRAIN = false; static_assert(ACT == 0 || ACT == 1, "EpiBf16: ACT is 0 (none) or 1 (gelu_pk)");
    bf16_t* O; int ldc; const float* bias; int split_cols; size_t split_stride; float scale0;
    __device__ __forceinline__ void operator()(const f32x4 (&acc)[2][2][4][2], const Unit& u, int wr, int wc, int fr, int fq) const {
        const int row0 = u.pm * BM + wr * 64 + fr; int colt = u.pn * BM; bf16_t* base = O;
        float sc = 1.f; if (split_cols) { const int t = colt / split_cols; base += (size_t)t * split_stride; colt -= t * split_cols; if (t == 0) sc = scale0; }
        const int col0 = colt + wc * 32 + 8 * fq, bcol0 = u.pn * BM + wc * 32 + 8 * fq;
        f32x4 bv[2][2];
#pragma unroll
        for (int bj = 0; bj < 2; ++bj)
#pragma unroll
            for (int n = 0; n < 2; ++n) bv[bj][n] = bias ? *(const f32x4*)(bias + bcol0 + bj * HALF + 4 * n) : (f32x4){0.f, 0.f, 0.f, 0.f};
#pragma unroll
        for (int ai = 0; ai < 2; ++ai)
#pragma unroll
            for (int m = 0; m < 4; ++m) { bf16_t* rowp = base + (size_t)(row0 + ai * HALF + m * 16) * ldc + col0;
#pragma unroll
                for (int bj = 0; bj < 2; ++bj) { f32x4 v0 = acc[ai][bj][m][0] + bv[bj][0], v1 = acc[ai][bj][m][1] + bv[bj][1];
                    if (ACT == 1) { f32x2 a = gelu_pk((f32x2){v0[0], v0[1]}), b = gelu_pk((f32x2){v0[2], v0[3]}), c = gelu_pk((f32x2){v1[0], v1[1]}), d = gelu_pk((f32x2){v1[2], v1[3]});
                        v0 = (f32x4){a.x, a.y, b.x, b.y}; v1 = (f32x4){c.x, c.y, d.x, d.y}; }
                    v0 = v0 * sc; v1 = v1 * sc; u32x4 w; w.x = cvt_pk_bf16(v0[0], v0[1]); w.y = cvt_pk_bf16(v0[2], v0[3]); w.z = cvt_pk_bf16(v1[0], v1[1]); w.w = cvt_pk_bf16(v1[2], v1[3]);
                    *(u32x4*)(rowp + bj * HALF) = w; } }
    }
};

struct EpiQKVH { static constexpr bool PERM = true, AFTER_DRAIN = false; bf16_t* O; int rows;
    __device__ __forceinline__ void operator()(const f32x4 (&acc)[2][2][4][2], const Unit& u, int wr, int wc, int fr, int fq) const {
        const int row0 = u.pm * BM + wr * 64 + fr, which = u.pn >> 3, head0 = 2 * (u.pn & 7), d = wc * 32 + 8 * fq;
#pragma unroll
        for (int ai = 0; ai < 2; ++ai)
#pragma unroll
            for (int m = 0; m < 4; ++m) { const int row = row0 + ai * HALF + m * 16;
#pragma unroll
                for (int bj = 0; bj < 2; ++bj) { const f32x4 v0 = acc[ai][bj][m][0], v1 = acc[ai][bj][m][1];
                    u32x4 w; w.x = cvt_pk_bf16(v0[0], v0[1]); w.y = cvt_pk_bf16(v0[2], v0[3]); w.z = cvt_pk_bf16(v1[0], v1[1]); w.w = cvt_pk_bf16(v1[2], v1[3]);
                    *(u32x4*)(O + ((size_t)((which * 16 + head0 + bj) * rows + row)) * 128 + d) = w; } }
    }
};
template <bool RBF16>
struct EpiRes { static constexpr bool PERM = false, AFTER_DRAIN = false; bf16_t* C; const void* R; int ldc; float alpha;
    __device__ __forceinline__ void operator()(const f32x4 (&acc)[2][2][4][2], const Unit& u, int wr, int wc, int fr, int fq) const {
        const int row0 = u.pm * BM + wr * 64 + fr, col0 = u.pn * BM + wc * 32 + 4 * fq;
        typedef unsigned v2u_ __attribute__((ext_vector_type(2)));
#pragma unroll
        for (int ai = 0; ai < 2; ++ai) {
            f32x4 rf[RBF16 ? 1 : 4][2][2]; v2u_ rb[RBF16 ? 4 : 1][2][2];
#pragma unroll
            for (int m = 0; m < 4; ++m) { const size_t ro = (size_t)(row0 + ai * HALF + m * 16) * ldc + col0;
#pragma unroll
                for (int bj = 0; bj < 2; ++bj)
#pragma unroll
                    for (int n = 0; n < 2; ++n) {
                        if constexpr (RBF16) rb[m][bj][n] = *(const v2u_*)((const bf16_t*)R + ro + bj * HALF + n * 16);
                        else rf[m][bj][n] = *(const f32x4*)((const float*)R + ro + bj * HALF + n * 16); } }
            __builtin_amdgcn_sched_barrier(0);
#pragma unroll
            for (int m = 0; m < 4; ++m) { const size_t ro = (size_t)(row0 + ai * HALF + m * 16) * ldc + col0;
#pragma unroll
                for (int bj = 0; bj < 2; ++bj)
#pragma unroll
                    for (int n = 0; n < 2; ++n) { f32x4 r;
                        if constexpr (RBF16) { const v2u_ p = rb[m][bj][n];
                            r = (f32x4){__builtin_bit_cast(float, p.x << 16), __builtin_bit_cast(float, p.x & 0xffff0000u), __builtin_bit_cast(float, p.y << 16), __builtin_bit_cast(float, p.y & 0xffff0000u)}; }
                        else r = rf[m][bj][n];
                        const f32x4 o = r * alpha + acc[ai][bj][m][n]; v2u_ w; w.x = cvt_pk_bf16(o[0], o[1]); w.y = cvt_pk_bf16(o[2], o[3]);
                        *(v2u_*)(C + ro + bj * HALF + n * 16) = w; } }
            __builtin_amdgcn_sched_barrier(0);
        }
    }
};
template <class Epi, class Sched, bool ALIGN_EPI = false, bool SP2 = false>
__device__ __forceinline__ void gemm_phase(PG8_LAS unsigned char* lds, const Gemm g, const Sched& S, const Epi& E) {
    const int tid = threadIdx.x, wid = __builtin_amdgcn_readfirstlane(tid >> 6), lane = tid & 63, wr = wid >> 2, wc = wid & 3, fr = lane & 15, fq = lane >> 4;
    const int K = g.K, nt = K / BK;
    unsigned voffA[2], voffB[2];
#pragma unroll
    for (int i = 0; i < 2; ++i) { int R, C; stage_rc(tid * 16 + i * 8192, R, C); const int Rb = Epi::PERM ? ((R & ~31) + perm32(R & 31)) : R;
        voffA[i] = (unsigned)(R * K + C) * 2u; voffB[i] = (unsigned)(Rb * K + C) * 2u; }
    const size_t kstep = (size_t)(BK * 2);
    const size_t hstep = (size_t)HALF * K * 2;
    const size_t tstep = 2 * hstep;
    const unsigned ldsw = (unsigned)wid * 1024u;
    const int aoff = lds_byte(wr * 64 + fr, fq * 8), boff = lds_byte(wc * 32 + fr, fq * 8);
#define PG8_SA(b, h) (((b) * 2 + (h)) * HTB)
#define PG8_SB(b, h) ((4 + (b) * 2 + (h)) * HTB)
#define PG8_STAGE(bufoff, gbase, voff) do { _Pragma("unroll") for (int _i = 0; _i < 2; ++_i) \
        __builtin_amdgcn_global_load_lds((const unsigned*)((const char*)(gbase) + (voff)[_i]), (PG8_LAS unsigned*)(lds + (bufoff) + ldsw + _i * 8192), 16, 0, 0); } while (0)
#define PG8_LDA(dst, b, h) do { _Pragma("unroll") for (int m = 0; m < 4; ++m) _Pragma("unroll") for (int k = 0; k < 2; ++k) dst[m][k] = *(const PG8_LAS bf16x8*)(lds + PG8_SA(b, h) + aoff + m * 2048 + k * 1024); } while (0)
#define PG8_LDB(dst, b, h) do { _Pragma("unroll") for (int n = 0; n < 2; ++n) _Pragma("unroll") for (int k = 0; k < 2; ++k) dst[n][k] = *(const PG8_LAS bf16x8*)(lds + PG8_SB(b, h) + boff + n * 2048 + k * 1024); } while (0)
#define PG8_MMA(ai, bj, At, Bt) do { __builtin_amdgcn_s_setprio(1); _Pragma("unroll") for (int m = 0; m < 4; ++m) _Pragma("unroll") for (int n = 0; n < 2; ++n) _Pragma("unroll") for (int k = 0; k < 2; ++k) \
        acc[ai][bj][m][n] = __builtin_amdgcn_mfma_f32_16x16x32_bf16(Bt[n][k], At[m][k], acc[ai][bj][m][n], 0, 0, 0); __builtin_amdgcn_s_setprio(0); } while (0)
#define PG8_WAIT_V(n) asm volatile("s_waitcnt vmcnt(" #n ")" ::: "memory")
#define PG8_WAIT_L(n) asm volatile("s_waitcnt lgkmcnt(" #n ")" ::: "memory")
#define PG8_BAR __builtin_amdgcn_s_barrier()
#define PG8_SCHED __builtin_amdgcn_sched_barrier(0)
    Unit cur, nxt; int ui = 0;
    if (!S.next(0, cur)) return;
    f32x4 acc[2][2][4][2];
#pragma unroll
    for (int a = 0; a < 2; ++a)
#pragma unroll
        for (int b = 0; b < 2; ++b)
#pragma unroll
            for (int m = 0; m < 4; ++m)
#pragma unroll
                for (int n = 0; n < 2; ++n) acc[a][b][m][n] = (f32x4){0.f, 0.f, 0.f, 0.f};
    bf16x8 At[4][2], B0[2][2], B1[2][2];
    const char* cA = (const char*)g.A + (size_t)cur.pm * tstep; const char* cB = (const char*)g.Bt + (size_t)cur.pn * tstep;
    S.a_ready(cur);
    if constexpr (SP2) {
        PG8_STAGE(PG8_SB(0, 0), cB, voffB); PG8_STAGE(PG8_SB(0, 1), cB + hstep, voffB); PG8_STAGE(PG8_SA(0, 0), cA, voffA); PG8_STAGE(PG8_SA(0, 1), cA + hstep, voffA);
        if (wr == 1) PG8_BAR;
        PG8_WAIT_V(2); PG8_BAR;
        PG8_STAGE(PG8_SB(1, 0), cB + kstep, voffB); PG8_STAGE(PG8_SA(1, 0), cA + kstep, voffA); PG8_STAGE(PG8_SB(1, 1), cB + hstep + kstep, voffB);
        PG8_WAIT_V(6); PG8_BAR;
    } else {
        PG8_STAGE(PG8_SB(0, 0), cB, voffB); PG8_STAGE(PG8_SA(0, 0), cA, voffA); PG8_STAGE(PG8_SB(0, 1), cB + hstep, voffB); PG8_STAGE(PG8_SA(0, 1), cA + hstep, voffA);
        if (wr == 1) PG8_BAR;
        PG8_WAIT_V(4); PG8_BAR;
        PG8_STAGE(PG8_SB(1, 0), cB + kstep, voffB); PG8_STAGE(PG8_SA(1, 0), cA + kstep, voffA); PG8_STAGE(PG8_SB(1, 1), cB + hstep + kstep, voffB);
        PG8_WAIT_V(6); PG8_BAR;
    }
    for (;;) {
        const bool has_next = S.next(ui + 1, nxt);
        const char* nA = has_next ? (const char*)g.A + (size_t)nxt.pm * tstep : cA; const char* nB = has_next ? (const char*)g.Bt + (size_t)nxt.pn * tstep : cB;
        for (int t = 0; t < nt; t += 2) {
            const bool last = (t == nt - 2);
            const char* a1 = cA + (size_t)(t + 1) * kstep;
            const char* a2 = last ? nA : cA + (size_t)(t + 2) * kstep; const char* b2 = last ? nB : cB + (size_t)(t + 2) * kstep;
            const char* a3 = a2 + kstep; const char* b3 = b2 + kstep;
            if (last && has_next) S.a_ready(nxt);
            if constexpr (SP2) {
            PG8_LDB(B0, 0, 0); PG8_LDB(B1, 0, 1); PG8_SCHED; PG8_LDA(At, 0, 0); PG8_STAGE(PG8_SA(1, 1), a1 + hstep, voffA);
            PG8_WAIT_V(8); PG8_WAIT_L(0); PG8_BAR; PG8_MMA(0, 0, At, B0); PG8_MMA(0, 1, At, B1); PG8_BAR; PG8_SCHED;
            PG8_LDA(At, 0, 1); PG8_STAGE(PG8_SB(0, 0), b2, voffB); PG8_STAGE(PG8_SB(0, 1), b2 + hstep, voffB); PG8_STAGE(PG8_SA(0, 0), a2, voffA);
            PG8_WAIT_V(8); PG8_WAIT_L(0); PG8_BAR; PG8_MMA(1, 0, At, B0); PG8_MMA(1, 1, At, B1); PG8_BAR; PG8_SCHED;
            PG8_LDB(B0, 1, 0); PG8_LDB(B1, 1, 1); PG8_SCHED; PG8_LDA(At, 1, 0); PG8_STAGE(PG8_SA(0, 1), a2 + hstep, voffA);
            PG8_WAIT_V(8); PG8_WAIT_L(0); PG8_BAR; PG8_MMA(0, 0, At, B0); PG8_MMA(0, 1, At, B1); PG8_BAR; PG8_SCHED;
            PG8_LDA(At, 1, 1); PG8_STAGE(PG8_SB(1, 0), b3, voffB); PG8_STAGE(PG8_SB(1, 1), b3 + hstep, voffB); PG8_STAGE(PG8_SA(1, 0), a3, voffA);
            PG8_WAIT_V(8); PG8_WAIT_L(0); PG8_BAR; PG8_MMA(1, 0, At, B0); PG8_MMA(1, 1, At, B1); PG8_BAR; PG8_SCHED;
            } else {
            PG8_LDB(B0, 0, 0); PG8_SCHED; PG8_LDA(At, 0, 0); PG8_STAGE(PG8_SA(1, 1), a1 + hstep, voffA);
            PG8_WAIT_L(8); PG8_BAR; PG8_WAIT_L(0); PG8_MMA(0, 0, At, B0); PG8_BAR; PG8_SCHED;
            PG8_LDB(B1, 0, 1); PG8_STAGE(PG8_SB(0, 0), b2, voffB);
            PG8_BAR; PG8_WAIT_L(0); PG8_MMA(0, 1, At, B1); PG8_BAR;
            PG8_LDA(At, 0, 1); PG8_STAGE(PG8_SA(0, 0), a2, voffA);
            PG8_BAR; PG8_WAIT_L(0); PG8_MMA(1, 0, At, B0); PG8_BAR; PG8_SCHED;
            PG8_STAGE(PG8_SB(0, 1), b2 + hstep, voffB);
            PG8_WAIT_V(6); PG8_BAR; PG8_MMA(1, 1, At, B1); PG8_BAR;
            PG8_LDB(B0, 1, 0); PG8_SCHED; PG8_LDA(At, 1, 0); PG8_STAGE(PG8_SA(0, 1), a2 + hstep, voffA);
            PG8_WAIT_L(8); PG8_BAR; PG8_WAIT_L(0); PG8_MMA(0, 0, At, B0); PG8_BAR; PG8_SCHED;
            PG8_LDB(B1, 1, 1); PG8_STAGE(PG8_SB(1, 0), b3, voffB);
            PG8_BAR; PG8_WAIT_L(0); PG8_MMA(0, 1, At, B1); PG8_BAR;
            PG8_LDA(At, 1, 1); PG8_STAGE(PG8_SA(1, 0), a3, voffA);
            PG8_BAR; PG8_WAIT_L(0); PG8_MMA(1, 0, At, B0); PG8_BAR; PG8_SCHED;
            PG8_STAGE(PG8_SB(1, 1), b3 + hstep, voffB);
            PG8_WAIT_V(6); PG8_BAR; PG8_MMA(1, 1, At, B1); PG8_BAR;
            }
        }
        if constexpr (ALIGN_EPI) { if (wr == 0) PG8_BAR; }
        if constexpr (!Epi::AFTER_DRAIN) { E(acc, cur, wr, wc, fr, fq); S.done(cur); }
        if (!has_next) break;
#pragma unroll
        for (int a = 0; a < 2; ++a)
#pragma unroll
            for (int b = 0; b < 2; ++b)
#pragma unroll
                for (int m = 0; m < 4; ++m)
#pragma unroll
                    for (int n = 0; n < 2; ++n) acc[a][b][m][n] = (f32x4){0.f, 0.f, 0.f, 0.f};
        cur = nxt; cA = nA; cB = nB; ++ui;
        if constexpr (ALIGN_EPI) { if (wr == 1) PG8_BAR; }
    }
    PG8_WAIT_V(0);
    if constexpr (!ALIGN_EPI) { if (wr == 0) PG8_BAR; }
    PG8_BAR;
    if constexpr (Epi::AFTER_DRAIN) { E.fused(acc, cur, wr, wc, fr, fq, lds, wid, lane); S.done(cur); }
#undef PG8_SA
#undef PG8_SB
#undef PG8_STAGE
#undef PG8_LDA
#undef PG8_LDB
#undef PG8_MMA
#undef PG8_WAIT_V
#undef PG8_WAIT_L
#undef PG8_BAR
#undef PG8_SCHED
}
}

#define GAS __attribute__((address_space(1)))
#define LAS __attribute__((address_space(3)))
typedef unsigned v4u __attribute__((ext_vector_type(4)));
typedef unsigned v2u __attribute__((ext_vector_type(2)));
typedef float f32x4 __attribute__((ext_vector_type(4)));
typedef short bf16x8 __attribute__((ext_vector_type(8)));
#define LDS_WAIT() asm volatile("s_waitcnt lgkmcnt(0)" ::: "memory")
#define VM_WAIT() asm volatile("s_waitcnt vmcnt(0)" ::: "memory")
__device__ __forceinline__ float bflo(unsigned u) { return __builtin_bit_cast(float, u << 16); }
__device__ __forceinline__ float bfhi(unsigned u) { return __builtin_bit_cast(float, u & 0xffff0000u); }
__device__ __forceinline__ void st8_wt(void* p, unsigned lo_, unsigned hi_) { typedef unsigned u2_ __attribute__((ext_vector_type(2))); const u2_ v = {lo_, hi_}; asm volatile("global_store_dwordx2 %0, %1, off sc1\n\ts_nop 1" :: "v"(p), "v"(v) : "memory"); }
__device__ __forceinline__ void st16_wt(void* p, unsigned a_, unsigned b_, unsigned c_, unsigned d_) { typedef unsigned u4_ __attribute__((ext_vector_type(4))); const u4_ v = {a_, b_, c_, d_}; asm volatile("global_store_dwordx4 %0, %1, off sc1\n\ts_nop 1" :: "v"(p), "v"(v) : "memory"); }
typedef __bf16 bf16x2_t __attribute__((ext_vector_type(2)));
typedef float f32x2_t __attribute__((ext_vector_type(2)));
__device__ __forceinline__ unsigned pk2(float lo, float hi) { const f32x2_t v = {lo, hi}; const bf16x2_t b = __builtin_convertvector(v, bf16x2_t); return __builtin_bit_cast(unsigned, b); }

constexpr int NWAVES = 8, NTHR = 512;
constexpr int RING_OFF = 0, RING_BYTES = 131072;
constexpr int LDS_BYTES = 147456;
constexpr int MISC_OFF = LDS_BYTES - 64;
constexpr int XTRA_OFF = RING_BYTES;
constexpr size_t WT_FOX_IN = WS_WT, WT_FOX_O = WS_WT + 24 * MiB, WT_GLA_IN = WS_WT + 32 * MiB, WT_GLA_O = WS_WT + 56 * MiB;
constexpr size_t WS_WGL = WS_WR + 2 * 72 * 2048 * 4;
constexpr size_t WS_WF = WS_GLA + 340 * MiB;

#define XB_TMO      128
#define XB_XCNT(j)  (256  + 64 * (j))
#define XB_XSUB(j)  (1280 + 64 * (j))
#define XB_XGEN(j)  (2304 + 64 * (j))
#define XB_TOP      3328
#define XB_TOPGEN   3392
#define XCD_BAR_WORDS 3456
#define XB_SPIN_CAP (1u << 18)
constexpr int CW_BAR = 4096;
__device__ __forceinline__ unsigned xb_ld(unsigned* p)              { return __hip_atomic_load(p, __ATOMIC_RELAXED, __HIP_MEMORY_SCOPE_AGENT); }
__device__ __forceinline__ unsigned xb_add(unsigned* p, unsigned v) { return __hip_atomic_fetch_add(p, v, __ATOMIC_RELAXED, __HIP_MEMORY_SCOPE_AGENT); }
__device__ __forceinline__ unsigned xb_xcc_id() { return (unsigned)__builtin_amdgcn_s_getreg((3 << 11) | 20) & 0xFu; }
#define XB_SPIN(cond, bar) do { unsigned _sp = 0; while (cond) { __builtin_amdgcn_s_sleep(1); \
    if ((++_sp & 255u) == 0u) { if (xb_ld(&(bar)[XB_TMO])) break; if (_sp > XB_SPIN_CAP) { atomicAdd(&(bar)[XB_TMO], 1u); break; } } } } while (0)
struct XcdBarrier { unsigned* bar; unsigned x; volatile LAS unsigned* st; };
__device__ __forceinline__ XcdBarrier xcd_barrier_post(unsigned* bar, volatile LAS unsigned* st) {
    XcdBarrier b; b.bar = bar; b.x = xb_xcc_id(); b.st = st;
    if (threadIdx.x == 0) (void)xb_add(&bar[XB_XCNT(b.x)], 1u);
    return b;
}
__device__ __forceinline__ void xcd_barrier_complete(unsigned* bar, unsigned x, unsigned& nloc, unsigned& nx) {
    const unsigned G = gridDim.x * gridDim.y * gridDim.z;
    unsigned sum, cnt, mine, sp = 0u;
    for (;;) {
        sum = 0u; cnt = 0u; mine = 0u;
#pragma unroll
        for (unsigned j = 0; j < 16; ++j) { const unsigned c = xb_ld(&bar[XB_XCNT(j)]); sum += c; cnt += (c > 0u) ? 1u : 0u; mine = (j == x) ? c : mine; }
        if (sum == G) break;
        __builtin_amdgcn_s_sleep(1);
        if ((++sp & 255u) == 0u) { if (xb_ld(&bar[XB_TMO])) break; if (sp > XB_SPIN_CAP) { atomicAdd(&bar[XB_TMO], 1u); break; } }
    }
    nloc = mine > 0u ? mine : 1u; nx = cnt > 0u ? cnt : 1u;
}
__device__ __forceinline__ void xcd_barrier(const XcdBarrier& b) {
    asm volatile("s_waitcnt vmcnt(0)" ::: "memory");
    __syncthreads();
    if (threadIdx.x == 0) {
        unsigned* bar = b.bar;
        __builtin_amdgcn_s_waitcnt(0);
        unsigned nloc = b.st[0], nx = b.st[1];
        if (nloc == 0u) { xcd_barrier_complete(bar, b.x, nloc, nx); b.st[0] = nloc; b.st[1] = nx; }
        const unsigned old = xb_add(&bar[XB_XSUB(b.x)], 1u);
        const unsigned gen = old / nloc;
        if (old + 1u == (gen + 1u) * nloc) {
            __builtin_amdgcn_fence(__ATOMIC_RELEASE, "agent");
            asm volatile("s_waitcnt vmcnt(0)" ::: "memory");
            const unsigned og = xb_add(&bar[XB_TOP], 1u);
            const unsigned tg = og / nx;
            if (og + 1u == (tg + 1u) * nx) xb_add(&bar[XB_TOPGEN], 1u);
            else XB_SPIN(xb_ld(&bar[XB_TOPGEN]) == tg, bar);
            __builtin_amdgcn_fence(__ATOMIC_ACQUIRE, "agent");
            xb_add(&bar[XB_XGEN(b.x)], 1u);
            asm volatile("s_waitcnt vmcnt(0)" ::: "memory");
        } else {
            XB_SPIN(xb_ld(&bar[XB_XGEN(b.x)]) == gen, bar);
            __builtin_amdgcn_fence(__ATOMIC_ACQUIRE, "agent");
            asm volatile("s_waitcnt vmcnt(0)" ::: "memory");
        }
    }
    __syncthreads();
}

struct Frame {
    LAS unsigned char* lds;
    unsigned* ctl;
    int tid, lane, wave, G, vcu;
};
__device__ __forceinline__ float wave_sum(float v) {
#pragma unroll
    for (int o = 1; o < 64; o <<= 1) v += __shfl_xor(v, o);
    return v;
}
template <int N, int MASK> __device__ __forceinline__ void rs_step(float* v, int lane) {
    const bool up = (lane & MASK) != 0;
#pragma unroll
    for (int i = 0; i < N / 2; ++i) { const float send = up ? v[i] : v[i + N / 2]; const float keep = up ? v[i + N / 2] : v[i]; v[i] = keep + __shfl_xor(send, MASK); }
}
__device__ __forceinline__ void rs64(float (&v)[64], int lane) { rs_step<64, 32>(v, lane); rs_step<32, 16>(v, lane); rs_step<16, 8>(v, lane); rs_step<8, 4>(v, lane); rs_step<4, 2>(v, lane); rs_step<2, 1>(v, lane); }
__device__ __forceinline__ void rs32(float (&v)[32], int lane) { rs_step<32, 32>(v, lane); rs_step<16, 16>(v, lane); rs_step<8, 8>(v, lane); rs_step<4, 4>(v, lane); rs_step<2, 2>(v, lane); v[0] += __shfl_xor(v[0], 1); }

typedef short s16x4 __attribute__((ext_vector_type(4)));
typedef short v4i16_t __attribute__((__vector_size__(4 * sizeof(short))));
__device__ __forceinline__ s16x4 lds_tr16(const LAS unsigned char* p) { return __builtin_bit_cast(s16x4, __builtin_amdgcn_ds_read_tr16_b64_v4i16((LAS v4i16_t*)p)); }
__device__ __forceinline__ void p0_transpose_item(const float* W, int ldw, int ncols, int K, bf16* WT, LAS unsigned char* scr, int item, int lane) {
    const int nblk = ncols / 64, kb0 = item / nblk, nb = item % nblk, k0 = 64 * kb0, n0 = 64 * nb;
    f32x4 w[16];
#pragma unroll
    for (int i = 0; i < 16; ++i) w[i] = __builtin_nontemporal_load((const f32x4*)(W + (size_t)(k0 + 4 * i + (lane >> 4)) * ldw + n0 + (lane & 15) * 4));
#pragma unroll
    for (int i = 0; i < 16; ++i) { v2u o; o.x = pk2(w[i].x, w[i].y); o.y = pk2(w[i].z, w[i].w); *(LAS v2u*)(scr + (4 * i + (lane >> 4)) * 192 + (lane & 15) * 8) = o; }
    LDS_WAIT(); asm volatile("" ::: "memory");
    const int tr_rd = (8 * (lane >> 5) + ((lane >> 2) & 3)) * 192 + (16 * ((lane >> 4) & 1) + 4 * (lane & 3)) * 2, tr_col = 16 * ((lane >> 4) & 1) + (lane & 15), tr_k = 8 * (lane >> 5);
#pragma unroll
    for (int st = 0; st < 8; ++st) { const int cb = (st >> 2) * 32, kb = (st & 3) * 16;
        const s16x4 l_ = lds_tr16(scr + kb * 192 + cb * 2 + tr_rd), h_ = lds_tr16(scr + (kb + 4) * 192 + cb * 2 + tr_rd);
        *(bf16x8*)(WT + (size_t)(n0 + cb + tr_col) * K + k0 + kb + tr_k) = (bf16x8){l_[0], l_[1], l_[2], l_[3], h_[0], h_[1], h_[2], h_[3]}; }
    LDS_WAIT(); asm volatile("" ::: "memory");
}
struct P0Args { const float* x; const float* fox_w_in; const float* fox_w_o; const float* gla_w_in; const float* gla_w_o; const float* w_group; const float* w_expert;
                bf16* wt_fox_in; bf16* wt_fox_o; bf16* wt_gla_in; bf16* wt_gla_o; float* WR; float* WGL; bf16* XB; float* FLOG; void* WF; };
__device__ __forceinline__ void p0_prologue(Frame& F, const P0Args& a) {
    LAS unsigned char* scr = F.lds + RING_OFF + F.wave * 16384;
    const int gw = F.vcu * NWAVES + F.wave, NGW = F.G * NWAVES;
    {
        LAS float* WfT = (LAS float*)(F.lds + RING_OFF);
#pragma unroll 4
        for (int i = 0; i < 16; ++i) { const int idx = F.tid + NTHR * i, k = idx >> 2, cg = idx & 3;
            const f32x4 w = *(const f32x4*)(a.fox_w_in + (size_t)k * NPROJ + NQKV + 4 * cg);
            WfT[(4 * cg + 0) * DM + k] = w.x; WfT[(4 * cg + 1) * DM + k] = w.y; WfT[(4 * cg + 2) * DM + k] = w.z; WfT[(4 * cg + 3) * DM + k] = w.w; }
        __syncthreads();
        for (int it = gw; it < T / 4; it += NGW) {
            const int row0 = it * 4;
            float acc[64];
#pragma unroll
            for (int i = 0; i < 64; ++i) acc[i] = 0.f;
#pragma unroll 1
            for (int j = 0; j < 8; ++j) {
                f32x4 xr[4];
#pragma unroll
                for (int r = 0; r < 4; ++r) { xr[r] = *((const f32x4*)(a.x + (size_t)(row0 + r) * DM) + 64 * j + F.lane);
                    v2u o; o.x = pk2(xr[r].x, xr[r].y); o.y = pk2(xr[r].z, xr[r].w); *((v2u*)(a.XB + (size_t)(row0 + r) * DM) + 64 * j + F.lane) = o; }
#pragma unroll
                for (int c = 0; c < 16; ++c) { const f32x4 w = *((const LAS f32x4*)(WfT + c * DM) + 64 * j + F.lane);
#pragma unroll
                    for (int r = 0; r < 4; ++r) acc[r * 16 + c] += (xr[r].x * w.x + xr[r].y * w.y) + (xr[r].z * w.z + xr[r].w * w.w); }
            }
            rs64(acc, F.lane);
            a.FLOG[(size_t)(F.lane & 15) * T + row0 + (F.lane >> 4)] = acc[0];
        }
        __syncthreads();
    }
    constexpr int I_IN = (DM / 64) * (NQKV / 64), I_O = (DM / 64) * (DM / 64);
    for (int it = gw; it < 2 * (I_IN + I_O); it += NGW) {
        int r = it;
        if (r < I_IN) { p0_transpose_item(a.fox_w_in, NPROJ, NQKV, DM, a.wt_fox_in, scr, r, F.lane); continue; } r -= I_IN;
        if (r < I_O) { p0_transpose_item(a.fox_w_o, DM, DM, DM, a.wt_fox_o, scr, r, F.lane); continue; } r -= I_O;
        if (r < I_IN) { p0_transpose_item(a.gla_w_in, NPROJ, NQKV, DM, a.wt_gla_in, scr, r, F.lane); continue; } r -= I_IN;
        p0_transpose_item(a.gla_w_o, DM, DM, DM, a.wt_gla_o, scr, r, F.lane);
    }
    {
        bf16* WF = (bf16*)a.WF;
        for (int i = F.vcu * NTHR + F.tid; i < 2 * 128 * 3 * 64; i += F.G * NTHR) {
            const int l = i / (128 * 3 * 64), rem = i % (128 * 3 * 64), s = rem / 192, nt = (rem % 192) / 64, ln = rem % 64, n = 32 * nt + (ln & 31), k0 = 16 * s + 8 * (ln >> 5);
            unsigned hi[4], lo[4];
#pragma unroll
            for (int jp = 0; jp < 4; ++jp) { float w0 = 0.f, w1 = 0.f;
                if (n < 64) { w0 = a.w_expert[((size_t)l * DM + k0 + 2 * jp) * 64 + n]; w1 = a.w_expert[((size_t)l * DM + k0 + 2 * jp + 1) * 64 + n]; }
                else if (n < 72) { w0 = a.w_group[((size_t)l * DM + k0 + 2 * jp) * 8 + (n - 64)]; w1 = a.w_group[((size_t)l * DM + k0 + 2 * jp + 1) * 8 + (n - 64)]; }
                hi[jp] = pk2(w0, w1); lo[jp] = pk2(w0 - bflo(hi[jp]), w1 - bfhi(hi[jp])); }
            v4u h4, l4; h4.x = hi[0]; h4.y = hi[1]; h4.z = hi[2]; h4.w = hi[3]; l4.x = lo[0]; l4.y = lo[1]; l4.z = lo[2]; l4.w = lo[3];
            *(v4u*)(WF + ((size_t)((l * 2 + 0) * 128 + s) * 3 + nt) * 512 + ln * 8) = h4;
            *(v4u*)(WF + ((size_t)((l * 2 + 1) * 128 + s) * 3 + nt) * 512 + ln * 8) = l4;
        }
    }
    {
        bf16* WFG = (bf16*)a.WF + (size_t)2 * 2 * 128 * 3 * 512;
        for (int i = F.vcu * NTHR + F.tid; i < 128 * 64; i += F.G * NTHR) { const int s = i >> 6, ln = i & 63, n = ln & 31, k0 = 16 * s + 8 * (ln >> 5);
            unsigned hi[4], lo[4];
#pragma unroll
            for (int jp = 0; jp < 4; ++jp) { float w0 = 0.f, w1 = 0.f;
                if (n < 16) { w0 = a.gla_w_in[(size_t)(k0 + 2 * jp) * NPROJ + NQKV + n]; w1 = a.gla_w_in[(size_t)(k0 + 2 * jp + 1) * NPROJ + NQKV + n]; }
                hi[jp] = pk2(w0, w1); lo[jp] = pk2(w0 - bflo(hi[jp]), w1 - bfhi(hi[jp])); }
            v4u h4, l4; h4.x = hi[0]; h4.y = hi[1]; h4.z = hi[2]; h4.w = hi[3]; l4.x = lo[0]; l4.y = lo[1]; l4.z = lo[2]; l4.w = lo[3];
            *(v4u*)(WFG + (size_t)s * 512 + ln * 8) = h4; *(v4u*)(WFG + (size_t)(128 + s) * 512 + ln * 8) = l4; }
    }
}
__device__ __forceinline__ void fox_cumsum(Frame& F, const float* FLOG, const float* b_f, float* CB, int h) {
    LAS float* red = (LAS float*)(F.lds + XTRA_OFF);
    const float bf = b_f[h];
    float lf[16]; float s = 0.f;
#pragma unroll
    for (int i = 0; i < 4; ++i) { const f32x4 v = *((const f32x4*)(FLOG + (size_t)h * T + F.tid * 16) + i); lf[4 * i] = v.x; lf[4 * i + 1] = v.y; lf[4 * i + 2] = v.z; lf[4 * i + 3] = v.w; }
#pragma unroll
    for (int i = 0; i < 16; ++i) { lf[i] = log_sigmoid(lf[i] + bf); s += lf[i]; }
    float inc = s;
#pragma unroll
    for (int o = 1; o < 64; o <<= 1) { const float t = __shfl_up(inc, o); if (F.lane >= o) inc += t; }
    if (F.lane == 63) red[F.wave] = inc;
    __syncthreads();
    float base = inc - s;
    for (int w = 0; w < F.wave; ++w) base += red[w];
#pragma unroll
    for (int i = 0; i < 16; ++i) { base += lf[i]; CB[(size_t)h * T + F.tid * 16 + i] = -base * (1.f / FOX_SCALE); }
    __syncthreads();
}


struct LnArgs { const bf16* Y; const bf16* X; const bf16* YE; int mode; const float* g; const float* b; float* XF; bf16* XBo;
                const float* WT; const float* bg; const float* be; int* TOPE; float* TOPG; unsigned* CNT; int* LIST; float* GLOW; };
__device__ __forceinline__ void ln_issue_chunk(Frame& F, const float* WT, int g, int buf) {
    const char* src = (const char*)(WT + (size_t)g * 8 * DM) + F.wave * 1024 + F.lane * 16;
    LAS unsigned char* dst = F.lds + RING_OFF + buf * 65536 + F.wave * 1024;
#pragma unroll 1
    for (int i = 0; i < 8; ++i) { __builtin_amdgcn_global_load_lds((const unsigned*)src, (LAS unsigned*)dst, 16, 0, 0); src += 8192; dst += 8192; }
}
template <int NG, int MODE>
__device__ __forceinline__ void ln_phase(Frame& F, const LnArgs& A) {
    for (int unit = F.vcu; unit < T / 32; unit += F.G) {
        const int row0 = unit * 32 + F.wave * 4;
        if (NG > 0 && NG != 9 && NG != 2) ln_issue_chunk(F, A.WT, 0, 0);
        f32x4 xr[4][8];
        if constexpr (MODE == 0) {
#pragma unroll
            for (int r = 0; r < 4; ++r)
#pragma unroll
                for (int j = 0; j < 8; ++j) { const v2u p = *((const v2u*)(A.Y + (size_t)(row0 + r) * DM) + 64 * j + F.lane); xr[r][j] = (f32x4){bflo(p.x), bfhi(p.x), bflo(p.y), bfhi(p.y)}; }
        } else if constexpr (MODE == 2) {
            v2u xraw[4][8], ya[16], yb[16];
#define LN_LOADY2(Y_, r_) do { _Pragma("unroll") for (int j = 0; j < 8; ++j) { Y_[j] = *((const v2u*)(A.Y + (size_t)(row0 + (r_)) * DM) + 64 * j + F.lane); Y_[8 + j] = *((const v2u*)(A.Y + (size_t)(row0 + (r_) + 1) * DM) + 64 * j + F.lane); } } while (0)
#define LN_ACCY2(Y_, r_) do { _Pragma("unroll") for (int j = 0; j < 8; ++j) { \
                xr[(r_)][j] = xr[(r_)][j] + (f32x4){bflo(Y_[j].x), bfhi(Y_[j].x), bflo(Y_[j].y), bfhi(Y_[j].y)}; \
                xr[(r_) + 1][j] = xr[(r_) + 1][j] + (f32x4){bflo(Y_[8 + j].x), bfhi(Y_[8 + j].x), bflo(Y_[8 + j].y), bfhi(Y_[8 + j].y)}; } } while (0)
#pragma unroll
            for (int r = 0; r < 4; ++r)
#pragma unroll
                for (int j = 0; j < 8; ++j) xraw[r][j] = *((const v2u*)(A.X + (size_t)(row0 + r) * DM) + 64 * j + F.lane);
            LN_LOADY2(ya, 0);
            __builtin_amdgcn_sched_barrier(0);
#pragma unroll
            for (int r = 0; r < 4; ++r)
#pragma unroll
                for (int j = 0; j < 8; ++j) { const v2u p = xraw[r][j]; xr[r][j] = (f32x4){bflo(p.x), bfhi(p.x), bflo(p.y), bfhi(p.y)} * ALPHA; }
            __builtin_amdgcn_sched_barrier(0);
            LN_LOADY2(yb, 2); __builtin_amdgcn_sched_barrier(0); LN_ACCY2(ya, 0); __builtin_amdgcn_sched_barrier(0);
            LN_ACCY2(yb, 2);
            __builtin_amdgcn_sched_barrier(0);
#undef LN_LOADY2
#undef LN_ACCY2
        } else {
            v2u xraw[4][8], ya[16], yb[16];
#define LN_LOADY(Y_, r_) do { _Pragma("unroll") for (int j = 0; j < 8; ++j) { Y_[j] = *((const v2u*)(A.YE + (size_t)(2 * (row0 + (r_))) * DM) + 64 * j + F.lane); Y_[8 + j] = *((const v2u*)(A.YE + (size_t)(2 * (row0 + (r_)) + 1) * DM) + 64 * j + F.lane); } } while (0)
#define LN_ACCY(Y_, r_) do { _Pragma("unroll") for (int j = 0; j < 8; ++j) { \
                xr[(r_)][j].x += __builtin_bit_cast(float, Y_[j].x << 16) + __builtin_bit_cast(float, Y_[8 + j].x << 16); \
                xr[(r_)][j].y += __builtin_bit_cast(float, Y_[j].x & 0xffff0000u) + __builtin_bit_cast(float, Y_[8 + j].x & 0xffff0000u); \
                xr[(r_)][j].z += __builtin_bit_cast(float, Y_[j].y << 16) + __builtin_bit_cast(float, Y_[8 + j].y << 16); \
                xr[(r_)][j].w += __builtin_bit_cast(float, Y_[j].y & 0xffff0000u) + __builtin_bit_cast(float, Y_[8 + j].y & 0xffff0000u); } } while (0)
#pragma unroll
            for (int r = 0; r < 4; ++r)
#pragma unroll
                for (int j = 0; j < 8; ++j) xraw[r][j] = *((const v2u*)(A.X + (size_t)(row0 + r) * DM) + 64 * j + F.lane);
            LN_LOADY(ya, 0);
            __builtin_amdgcn_sched_barrier(0);
#pragma unroll
            for (int r = 0; r < 4; ++r)
#pragma unroll
                for (int j = 0; j < 8; ++j) { const v2u p = xraw[r][j]; xr[r][j] = (f32x4){bflo(p.x), bfhi(p.x), bflo(p.y), bfhi(p.y)} * ALPHA; }
            __builtin_amdgcn_sched_barrier(0);
            LN_LOADY(yb, 1); __builtin_amdgcn_sched_barrier(0); LN_ACCY(ya, 0); __builtin_amdgcn_sched_barrier(0);
            LN_LOADY(ya, 2); __builtin_amdgcn_sched_barrier(0); LN_ACCY(yb, 1); __builtin_amdgcn_sched_barrier(0);
            LN_LOADY(yb, 3); __builtin_amdgcn_sched_barrier(0); LN_ACCY(ya, 2); __builtin_amdgcn_sched_barrier(0);
            LN_ACCY(yb, 3);
            __builtin_amdgcn_sched_barrier(0);
#undef LN_LOADY
#undef LN_ACCY
        }
        f32x4 gg[8], bb8[8];
        {   const __amdgpu_buffer_rsrc_t grs = __builtin_amdgcn_make_buffer_rsrc((void*)A.g, 0, DM * 4, 0x00020000), brs = __builtin_amdgcn_make_buffer_rsrc((void*)A.b, 0, DM * 4, 0x00020000);
#pragma unroll
            for (int j = 0; j < 8; ++j) { gg[j] = __builtin_bit_cast(f32x4, __builtin_amdgcn_raw_buffer_load_b128(grs, F.lane * 16, 1024 * j, 0)); bb8[j] = __builtin_bit_cast(f32x4, __builtin_amdgcn_raw_buffer_load_b128(brs, F.lane * 16, 1024 * j, 0)); } }
        __builtin_amdgcn_sched_barrier(0);
        float rstd[4];
#pragma unroll
        for (int r = 0; r < 4; ++r) {
            float s = 0.f;
#pragma unroll
            for (int j = 0; j < 8; ++j) s += (xr[r][j].x + xr[r][j].y) + (xr[r][j].z + xr[r][j].w);
            const float mu = wave_sum(s) * (1.f / DM); float s2 = 0.f;
#pragma unroll
            for (int j = 0; j < 8; ++j) { xr[r][j] = xr[r][j] - mu; s2 += (xr[r][j].x * xr[r][j].x + xr[r][j].y * xr[r][j].y) + (xr[r][j].z * xr[r][j].z + xr[r][j].w * xr[r][j].w); }
            rstd[r] = 1.f / sqrtf(wave_sum(s2) * (1.f / DM) + LN_EPS);
        }
#pragma unroll
        for (int j = 0; j < 8; ++j) { const f32x4 g4 = gg[j], b4 = bb8[j];
#pragma unroll
            for (int r = 0; r < 4; ++r) { const f32x4 o = xr[r][j] * rstd[r] * g4 + b4; xr[r][j] = o;
                if (A.XF) __builtin_nontemporal_store(o, (f32x4*)(A.XF + (size_t)(row0 + r) * DM) + 64 * j + F.lane);
                if (A.XBo) { v2u p; p.x = pk2(o.x, o.y); p.y = pk2(o.z, o.w); *((v2u*)(A.XBo + (size_t)(row0 + r) * DM) + 64 * j + F.lane) = p; } } }
        if constexpr (NG == 9 || NG == 2) {
            constexpr int NTL = NG == 9 ? 3 : 1, NCOL = NG == 9 ? 72 : 16;
            typedef float f32x16 __attribute__((ext_vector_type(16)));
            constexpr int XP = 4112, CSO = 0, LSO = 32 * XP;
            const bf16* WFb = (const bf16*)A.WT;
            f32x16 ca[NTL];
#pragma unroll
            for (int nt = 0; nt < NTL; ++nt) ca[nt] = f32x16{};
            constexpr int UG = NTL == 3 ? 2 : 8;
            bf16x8 fa[UG][2 * NTL], fb[UG][2 * NTL];
            const __amdgpu_buffer_rsrc_t wrs = __builtin_amdgcn_make_buffer_rsrc((void*)WFb, 0, 2 * 128 * NTL * 1024, 0x00020000);
            const int wv_ = F.lane * 16, ws_ = F.wave * NTL * 1024;
#define LN_LOADF(f, u0) do { _Pragma("unroll") for (int uu = 0; uu < UG; ++uu) { \
                _Pragma("unroll") for (int nt = 0; nt < NTL; ++nt) { f[uu][nt] = __builtin_bit_cast(bf16x8, __builtin_amdgcn_raw_buffer_load_b128(wrs, wv_, ws_ + ((u0) + uu) * 8 * NTL * 1024 + nt * 1024, 0)); \
                    f[uu][NTL + nt] = __builtin_bit_cast(bf16x8, __builtin_amdgcn_raw_buffer_load_b128(wrs, wv_, ws_ + 128 * NTL * 1024 + ((u0) + uu) * 8 * NTL * 1024 + nt * 1024, 0)); } } } while (0)
#define LN_MFMAS(f, u0) do { _Pragma("unroll") for (int uu = 0; uu < UG; ++uu) { const bf16x8 ah = *(const LAS bf16x8*)(xa + (F.wave + 8 * ((u0) + uu)) * 32); \
                _Pragma("unroll") for (int nt = 0; nt < NTL; ++nt) { ca[nt] = __builtin_amdgcn_mfma_f32_32x32x16_bf16(ah, f[uu][nt], ca[nt], 0, 0, 0); ca[nt] = __builtin_amdgcn_mfma_f32_32x32x16_bf16(ah, f[uu][NTL + nt], ca[nt], 0, 0, 0); } } } while (0)
            __syncthreads();
#pragma unroll
            for (int r = 0; r < 4; ++r)
#pragma unroll
                for (int j = 0; j < 8; ++j) { const f32x4 v = xr[r][j]; v2u h; h.x = pk2(v.x, v.y); h.y = pk2(v.z, v.w);
                    *(LAS v2u*)(F.lds + (F.wave * 4 + r) * XP + (256 * j + 4 * F.lane) * 2) = h; }
            LN_LOADF(fa, 0);
            __syncthreads();
            {   const LAS unsigned char* xa = F.lds + (F.lane & 31) * XP + (F.lane >> 5) * 16;
#pragma unroll
                for (int u = 0; u < 16; u += 2 * UG) {
                    LN_LOADF(fb, u + UG);
                    __builtin_amdgcn_sched_barrier(0);
                    LN_MFMAS(fa, u);
                    __builtin_amdgcn_sched_barrier(0);
                    if (u + 2 * UG < 16) LN_LOADF(fa, u + 2 * UG);
                    __builtin_amdgcn_sched_barrier(0);
                    LN_MFMAS(fb, u + UG);
                    __builtin_amdgcn_sched_barrier(0);
                }
            }
#undef LN_LOADF
#undef LN_MFMAS
            __syncthreads();
            {   LAS float* cs = (LAS float*)(F.lds + CSO) + F.wave * (32 * 32 * NTL);
#pragma unroll
                for (int nt = 0; nt < NTL; ++nt)
#pragma unroll
                    for (int r = 0; r < 16; ++r) cs[((r & 3) + 8 * (r >> 2) + 4 * (F.lane >> 5)) * (32 * NTL) + 32 * nt + (F.lane & 31)] = ca[nt][r]; }
            __syncthreads();
            {   LAS float* ls = (LAS float*)(F.lds + LSO);
                for (int idx = F.tid; idx < 32 * NCOL; idx += NTHR) { const int row = idx / NCOL, col = idx % NCOL; float s = 0.f;
#pragma unroll
                    for (int w8 = 0; w8 < 8; ++w8) s += ((const LAS float*)(F.lds + CSO))[w8 * (32 * 32 * NTL) + row * (32 * NTL) + col];
                    if constexpr (NG == 2) A.GLOW[(size_t)(unit * 32 + row) * 16 + col] = s; else ls[row * NCOL + col] = s; } }
            __syncthreads();
            if constexpr (NG == 9) {   const int rr = F.lane >> 4, t = row0 + rr; const LAS float* lr = (const LAS float*)(F.lds + LSO) + (F.wave * 4 + rr) * 72;
                float gl[8]; int gi = 0; float gm = -1e30f;
#pragma unroll
                for (int i = 0; i < 8; ++i) { gl[i] = lr[64 + i] + A.bg[i]; if (gl[i] > gm) { gm = gl[i]; gi = i; } }
                float gs = 0.f;
#pragma unroll
                for (int i = 0; i < 8; ++i) gs += __expf(gl[i] - gm);
                const float grp_p = 1.f / gs;
                float el[8]; int i1 = 0; float m1 = -1e30f;
#pragma unroll
                for (int i = 0; i < 8; ++i) { el[i] = lr[gi * 8 + i] + A.be[gi * 8 + i]; if (el[i] > m1) { m1 = el[i]; i1 = i; } }
                int i2 = 0; float m2 = -1e30f;
#pragma unroll
                for (int i = 0; i < 8; ++i) { if (i != i1 && el[i] > m2) { m2 = el[i]; i2 = i; } }
                const float e2 = __expf(m2 - m1), p1 = 1.f / (1.f + e2), p2 = e2 / (1.f + e2);
                if ((F.lane & 15) == 0) {
                    const int ex1 = gi * 8 + i1, ex2 = gi * 8 + i2;
                    A.TOPE[2 * t] = ex1; A.TOPE[2 * t + 1] = ex2; A.TOPG[2 * t] = grp_p * p1; A.TOPG[2 * t + 1] = grp_p * p2;
                    if (A.CNT) { const unsigned q1 = atomicAdd(&A.CNT[ex1], 1u); A.LIST[ex1 * T + q1] = 2 * t;
                    const unsigned q2 = atomicAdd(&A.CNT[ex2], 1u); A.LIST[ex2 * T + q2] = 2 * t + 1; }
                }
            }
            __syncthreads();
        } else if constexpr (NG > 0) {
            float res[NG];
#pragma unroll
            for (int k = 0; k < NG; ++k) res[k] = 0.f;
#pragma unroll 1
            for (int g = 0; g < NG; ++g) {
                VM_WAIT(); __syncthreads();
                if (g + 1 < NG) ln_issue_chunk(F, A.WT, g + 1, (g + 1) & 1);
                float acc[32];
#pragma unroll
                for (int i = 0; i < 32; ++i) acc[i] = 0.f;
                const LAS f32x4* wb = (const LAS f32x4*)(F.lds + RING_OFF + (g & 1) * 65536) + F.lane;
#pragma unroll
                for (int c = 0; c < 8; ++c) {
#pragma unroll
                    for (int j = 0; j < 8; ++j) { const f32x4 w = wb[c * 512 + 64 * j];
#pragma unroll
                        for (int r = 0; r < 4; ++r) acc[r * 8 + c] += (xr[r][j].x * w.x + xr[r][j].y * w.y) + (xr[r][j].z * w.z + xr[r][j].w * w.w); }
                    __builtin_amdgcn_sched_barrier(0);
                }
                rs32(acc, F.lane);
#pragma unroll
                for (int k = 0; k < NG; ++k) res[k] = (g == k) ? acc[0] : res[k];
            }
            const int rr = F.lane >> 4, cc = (F.lane >> 1) & 7, t = row0 + rr;
            if constexpr (NG == 2) {
                if ((F.lane & 1) == 0) { A.GLOW[(size_t)t * 16 + cc] = res[0]; A.GLOW[(size_t)t * 16 + 8 + cc] = res[1]; }
            } else {
                float gl[8]; int gi = 0; float gm = -1e30f;
#pragma unroll
                for (int i = 0; i < 8; ++i) { gl[i] = __shfl(res[NG - 1], (F.lane & 48) + 2 * i) + A.bg[i]; if (gl[i] > gm) { gm = gl[i]; gi = i; } }
                float gs = 0.f;
#pragma unroll
                for (int i = 0; i < 8; ++i) gs += expf(gl[i] - gm);
                const float grp_p = 1.f / gs;
                float sel = res[0];
#pragma unroll
                for (int i = 1; i < 8; ++i) sel = (gi == i) ? res[i] : sel;
                float el[8]; int i1 = 0; float m1 = -1e30f;
#pragma unroll
                for (int i = 0; i < 8; ++i) { el[i] = __shfl(sel, (F.lane & 48) + 2 * i) + A.be[gi * 8 + i]; if (el[i] > m1) { m1 = el[i]; i1 = i; } }
                int i2 = 0; float m2 = -1e30f;
#pragma unroll
                for (int i = 0; i < 8; ++i) { if (i != i1 && el[i] > m2) { m2 = el[i]; i2 = i; } }
                const float e2 = expf(m2 - m1), p1 = 1.f / (1.f + e2), p2 = e2 / (1.f + e2);
                if ((F.lane & 15) == 0) {
                    const int ex1 = gi * 8 + i1, ex2 = gi * 8 + i2;
                    A.TOPE[2 * t] = ex1; A.TOPE[2 * t + 1] = ex2; A.TOPG[2 * t] = grp_p * p1; A.TOPG[2 * t + 1] = grp_p * p2;
                    if (A.CNT) { const unsigned q1 = atomicAdd(&A.CNT[ex1], 1u); A.LIST[ex1 * T + q1] = 2 * t;
                    const unsigned q2 = atomicAdd(&A.CNT[ex2], 1u); A.LIST[ex2 * T + q2] = 2 * t + 1; }
                }
            }
            __syncthreads();
        }
    }
}


struct MoeArgs { const unsigned* CNT; const int* LIST; const float* TOPG; const bf16* XB; const float* Wg; const float* Wu; const float* Wd; bf16* HID; bf16* YE; unsigned* FLG; };
__device__ __forceinline__ int swz10(int ob) { return ob ^ (((ob >> 9) & 1) << 5); }
template <int MODE, int VAR = 0>
__device__ __forceinline__ void moe_phase(Frame& F, const MoeArgs& A) {
    constexpr int K = MODE == 0 ? DM : EFF, NKT = K / 64, NCH = MODE == 0 ? 2 : 4, NIT = NKT * NCH, NUNITS = NEXP * 4, LDW = MODE == 0 ? EFF : DM, CSTEP = MODE == 0 ? 64 : 128;
    constexpr int ABYTES = 384 * 128, BPITCH = 288, BBYTES = 64 * BPITCH, BOFF = 2 * ABYTES, TOFF = BOFF + 2 * BBYTES;
    static_assert(NIT % 2 == 0 && NKT % 2 == 0, "K-loop unrolled by 2");
    LAS int* pre = (LAS int*)(F.lds + TOFF);
    LAS int* rinfo = pre + 80;
    LAS float* rgate = (LAS float*)(rinfo + 384);
    const int tid = F.tid, lane = F.lane, wid = F.wave, wr = wid >> 1, wc = wid & 1, fr = lane & 15, fq = lane >> 4;
    if (tid == 0) { int s = 0; for (int e = 0; e < NEXP; ++e) { pre[e] = s; s += (int)A.CNT[e]; } pre[NEXP] = s; }
    __syncthreads();
    const int lo = swz10(fr * 64 + fq * 16);
    const int a_q = tid & 7, a_dst = (a_q >> 2) * 24576 + (tid >> 7) * 1024 + swz10(((tid >> 3) & 15) * 64 + (a_q & 3) * 16);
    const int b_g4 = tid & 31, b_kr = tid >> 5;
    const unsigned b_woff = (unsigned)(b_kr * DM + 4 * b_g4);
    const int b_dst = b_kr * BPITCH + (MODE == 1 ? 128 * (b_g4 >> 4) + 32 * (b_g4 & 3) + 8 * ((b_g4 >> 2) & 3) : b_g4 * 8);
    const int b_rd = (8 * fq + (fr >> 2)) * BPITCH + (fr & 3) * 8 + wc * 128;
    for (int unit = F.vcu; unit < NUNITS; unit += F.G) {
        const int e = unit >> 2, chunk0 = NCH * (unit & 3);
        const int n_e = (int)A.CNT[e], off_e = pre[e];
        const float* wp0;
        if (MODE == 0) { const int nt = (b_g4 >> 2) & 3; wp0 = (nt < 2 ? A.Wg : A.Wu) + (size_t)e * DM * EFF + (size_t)b_kr * EFF + chunk0 * 64 + 32 * (b_g4 >> 4) + 8 * (b_g4 & 3) + 4 * (nt & 1); }
        else wp0 = A.Wd + (size_t)e * EFF * DM + chunk0 * 128;
        if (MODE == 1) {
            if (wid == 0) { unsigned sp = 0;
                while ((unsigned)__builtin_amdgcn_readfirstlane(__hip_atomic_load(A.FLG + 64 * e, __ATOMIC_RELAXED, __HIP_MEMORY_SCOPE_AGENT)) < 4u) { __builtin_amdgcn_s_sleep(2); if (++sp > (1u << 22)) break; }
                __builtin_amdgcn_fence(__ATOMIC_ACQUIRE, "agent");
                asm volatile("s_waitcnt vmcnt(0)" ::: "memory"); }
            __syncthreads();
        }
        for (int p0 = 0; p0 < n_e; p0 += 384) {
            const int nrows = (n_e - p0) < 384 ? (n_e - p0) : 384;
            __syncthreads();
            if (tid < 384) { const int a = tid < nrows ? A.LIST[e * T + p0 + tid] : 0;
                if (MODE == 0) rinfo[tid] = (a >> 1) * (DM * 2); else { rinfo[tid] = a; rgate[tid] = tid < nrows ? A.TOPG[a] : 0.f; } }
            __syncthreads();
            const unsigned aoff1 = (unsigned)(off_e + p0 + (tid >> 3)) * (EFF * 2) + a_q * 16;
            const LAS int* rinfo_t = rinfo + (tid >> 3);
            const __amdgpu_buffer_rsrc_t ars = __builtin_amdgcn_make_buffer_rsrc((void*)(MODE == 0 ? A.XB : A.HID), 0, MODE == 0 ? T * DM * 2 : (2 * T + 512) * EFF * 2, 0x00020000);
            const int ntile = (nrows + 15) >> 4;
            int mtv = (ntile - wr + 3) >> 2; mtv = mtv < 0 ? 0 : (mtv > 6 ? 6 : mtv);
            f32x4 acc[6][4];
#pragma unroll
            for (int m = 0; m < 6; ++m)
#pragma unroll
                for (int n = 0; n < 4; ++n) acc[m][n] = (f32x4){0.f, 0.f, 0.f, 0.f};
            bf16x8 ar[6] = {}; f32x4 br0[4] = {}, br1[4] = {};
#define MOE_LOADA(it) do { if (!(VAR & 1)) _Pragma("unroll") for (int i = 0; i < 6; ++i) { const unsigned ao_ = MODE == 0 ? (unsigned)rinfo_t[64 * i] + a_q * 16 : aoff1 + (unsigned)i * (64u * EFF * 2u); \
                          ar[i] = __builtin_bit_cast(bf16x8, __builtin_amdgcn_raw_buffer_load_b128(ars, ao_, ((it) % NKT) * 128, 0)); } } while (0)
#define MOE_LOADB(R, it) do { const float* wp_ = wp0 + (size_t)((it) % NKT) * 64 * LDW + ((it) / NKT) * CSTEP; if (!(VAR & 2)) _Pragma("unroll") for (int j = 0; j < 4; ++j) R[j] = __builtin_nontemporal_load((const f32x4*)(wp_ + (size_t)j * 16 * LDW + (MODE == 0 ? 0u : b_woff))); } while (0)
#define MOE_WRITEA(buf) do { LAS unsigned char* ab_ = F.lds + (buf) * ABYTES + a_dst; _Pragma("unroll") for (int i = 0; i < 6; ++i) *(LAS bf16x8*)(ab_ + i * 4096) = ar[i]; } while (0)
#define MOE_WRITEB(R, buf) do { LAS unsigned char* bb_ = F.lds + BOFF + (buf) * BBYTES + b_dst; \
                            _Pragma("unroll") for (int j = 0; j < 4; ++j) { v2u w_; w_.x = pk2(R[j].x, R[j].y); w_.y = pk2(R[j].z, R[j].w); *(LAS v2u*)(bb_ + j * 16 * BPITCH) = w_; } } while (0)
#define MOE_COMPUTE(buf) do { const LAS unsigned char* ab = F.lds + (buf) * ABYTES + lo + wr * 1024; \
                const LAS unsigned char* bb = F.lds + BOFF + (buf) * BBYTES + b_rd; \
                _Pragma("unroll") for (int s = 0; s < 2; ++s) { bf16x8 af[6], bfr_[4]; \
                    _Pragma("unroll") for (int n = 0; n < 4; ++n) { const s16x4 l_ = lds_tr16(bb + s * 32 * BPITCH + n * 32), h_ = lds_tr16(bb + s * 32 * BPITCH + n * 32 + 4 * BPITCH); \
                        bfr_[n] = (bf16x8){l_[0], l_[1], l_[2], l_[3], h_[0], h_[1], h_[2], h_[3]}; } \
                    _Pragma("unroll") for (int m = 0; m < 6; ++m) af[m] = *(const LAS bf16x8*)(ab + s * 24576 + m * 4096); \
                    if (!(VAR & 4)) _Pragma("unroll") for (int m = 0; m < 6; ++m) if (m < mtv) { \
                        _Pragma("unroll") for (int n = 0; n < 4; ++n) acc[m][n] = __builtin_amdgcn_mfma_f32_16x16x32_bf16(bfr_[n], af[m], acc[m][n], 0, 0, 0); } } } while (0)
#define MOE_BAR() asm volatile("s_waitcnt lgkmcnt(0)\n\ts_barrier" ::: "memory")
#define MOE_EPI(ci) do { const int chunk = chunk0 + (ci); \
                _Pragma("unroll") for (int m = 0; m < 6; ++m) { const int row = 16 * (wr + 4 * m) + fr; \
                    if (row < nrows) { \
                        if (MODE == 0) { bf16* hp = A.HID + (size_t)(off_e + p0 + row) * EFF + chunk * 64 + 32 * wc + 8 * fq; \
                            const f32x4 g0 = acc[m][0], u0 = acc[m][2], g1 = acc[m][1], u1 = acc[m][3]; \
                            st16_wt(hp, pk2(silu(g0.x) * u0.x, silu(g0.y) * u0.y), pk2(silu(g0.z) * u0.z, silu(g0.w) * u0.w), pk2(silu(g1.x) * u1.x, silu(g1.y) * u1.y), pk2(silu(g1.z) * u1.z, silu(g1.w) * u1.w)); } \
                        else { const float gt = rgate[row]; bf16* yp = A.YE + (size_t)rinfo[row] * DM + chunk * 128 + 64 * wc + 16 * fq; \
                            _Pragma("unroll") for (int np = 0; np < 2; ++np) { const f32x4 y0 = acc[m][2 * np] * gt, y1 = acc[m][2 * np + 1] * gt; v4u o; o.x = pk2(y0.x, y0.y); o.y = pk2(y0.z, y0.w); o.z = pk2(y1.x, y1.y); o.w = pk2(y1.z, y1.w); *(v4u*)(yp + 8 * np) = o; } } } \
                    _Pragma("unroll") for (int n = 0; n < 4; ++n) acc[m][n] = (f32x4){0.f, 0.f, 0.f, 0.f}; } } while (0)
            MOE_LOADA(0); MOE_LOADB(br0, 0); MOE_LOADB(br1, 1);
            MOE_WRITEA(0); MOE_LOADA(1); MOE_WRITEB(br0, 0);
            MOE_BAR();
#pragma unroll 1
            for (int it = 0; it < NIT; it += 2) {
                const int i2 = it + 2 < NIT ? it + 2 : NIT - 1, i3 = it + 3 < NIT ? it + 3 : NIT - 1;
                MOE_LOADB(br0, i2);
                MOE_COMPUTE(0);
                MOE_WRITEA(1); MOE_LOADA(i2); MOE_WRITEB(br1, 1);
                MOE_BAR();
                MOE_LOADB(br1, i3);
                MOE_COMPUTE(1);
                if (NCH > 1 && (it + 1) % NKT == NKT - 1) MOE_EPI((it + 1) / NKT);
                MOE_WRITEA(0); MOE_LOADA(i3); MOE_WRITEB(br0, 0);
                MOE_BAR();
            }
            if (NCH == 1) MOE_EPI(0);
#undef MOE_LOADA
#undef MOE_LOADB
#undef MOE_WRITEA
#undef MOE_WRITEB
#undef MOE_COMPUTE
#undef MOE_BAR
#undef MOE_EPI
        }
        if (MODE == 0) {
            asm volatile("s_waitcnt vmcnt(0)" ::: "memory");
            __syncthreads();
            if (tid == 0 && A.FLG) __hip_atomic_fetch_add(A.FLG + 64 * e, 1u, __ATOMIC_RELAXED, __HIP_MEMORY_SCOPE_AGENT);
        }
    }
}

namespace fox {
typedef short s16x4 __attribute__((ext_vector_type(4)));
typedef float f32x16 __attribute__((ext_vector_type(16)));
typedef unsigned u32x4 __attribute__((ext_vector_type(4)));
constexpr int D = 128, PITCH = 128, OPITCH = DM;
constexpr unsigned KOFF = 16u * T * 128u * 2u, VOFF = 32u * T * 128u * 2u;
constexpr float SCALE = FOX_SCALE;
constexpr float THR = 8.f;
constexpr int NW = 8, QBLK = 32, KVBLK = 64, QB = NW * QBLK;
constexpr int SHM_V = KVBLK * D * 2, SHM_K = KVBLK * D * 2;
constexpr int WS_OFF = 2 * SHM_V + 2 * SHM_K, BIAS_OFF = WS_OFF + NW * 64 * 4;
constexpr int LDS_NEED = BIAS_OFF + 2 * 64 * 4;
#define KSWZ(row, colB) ((row) * 256 + ((colB) ^ (((row) & 7) << 4)))
#define SBAR() __builtin_amdgcn_sched_barrier(0)
__device__ __forceinline__ int v_st(int k, int c) { const int kk = (k & ~0xC) | ((k & 4) << 1) | ((k & 8) >> 1); return ((kk >> 3) * 4 + (c >> 5)) * 512 + ((kk & 7) * 32 + (c & 31)) * 2; }
__device__ __forceinline__ int v_rd_base(int lane) { return ((lane & 3) << 3) | (((lane >> 2) & 3) << 6) | (((lane >> 4) & 1) << 5) | (((lane >> 5) & 1) << 8); }
constexpr int v_rd_off(int d0, int ks, int half) { return d0 * 512 + ks * 4096 + half * 2048; }
__device__ __forceinline__ int crow(int r, int hi) { return (r & 3) + 8 * (r >> 2) + 4 * hi; }
__device__ __forceinline__ unsigned cvtpk(float lo, float hi) { unsigned r; asm volatile("v_cvt_pk_bf16_f32 %0, %1, %2" : "=v"(r) : "v"(lo), "v"(hi)); return r; }
__device__ __forceinline__ bf16x8 load8(const bf16* p) { return *reinterpret_cast<const bf16x8*>(p); }
__device__ __forceinline__ void mask_tile(f32x16& p0, f32x16& p1, int dq, unsigned W) {
    const float NEG = -__builtin_inff();
#pragma unroll
    for (int r = 0; r < 16; ++r) {
        const int c = (r & 3) + 8 * (r >> 2);
        if ((unsigned)(dq - c) >= W) p0[r] = NEG;
        if ((unsigned)(dq - c - 32) >= W) p1[r] = NEG;
    }
}
__device__ __forceinline__ void partialSM(f32x16& p0, f32x16& p1, float& m_reg, float& mn, float& alpha) {
    float pmax = p0[0]; for (int r = 1; r < 16; ++r) pmax = fmaxf(pmax, p0[r]); for (int r = 0; r < 16; ++r) pmax = fmaxf(pmax, p1[r]);
    { auto rr = __builtin_amdgcn_permlane32_swap(__float_as_uint(pmax), __float_as_uint(pmax), false, false);
      pmax = fmaxf(__uint_as_float(rr[0]), __uint_as_float(rr[1])); }
    constexpr float C2 = 1.4426950408889634f * SCALE;
    if (__builtin_expect(__all((pmax - m_reg) * SCALE <= THR), 1)) { mn = m_reg; alpha = 1.f; }
    else { mn = fmaxf(m_reg, pmax); alpha = __builtin_amdgcn_exp2f((m_reg - mn) * C2); m_reg = mn; }
    const float mnL = -mn * C2;
    for (int r = 0; r < 16; ++r) p0[r] = fmaf(p0[r], C2, mnL); for (int r = 0; r < 16; ++r) p1[r] = fmaf(p1[r], C2, mnL);
    for (int r = 0; r < 16; ++r) p0[r] = __builtin_amdgcn_exp2f(p0[r]);
}
__device__ __forceinline__ void finishSM(f32x16& p0, f32x16& p1, float alpha, float& l_reg, bf16x8& pa0, bf16x8& pa1, bf16x8& pa2, bf16x8& pa3) {
    for (int r = 0; r < 16; ++r) p1[r] = __builtin_amdgcn_exp2f(p1[r]);
    float ps = 0; for (int r = 0; r < 16; ++r) ps += p0[r]; for (int r = 0; r < 16; ++r) ps += p1[r];
    { auto rr = __builtin_amdgcn_permlane32_swap(__float_as_uint(ps), __float_as_uint(ps), false, false);
      ps = __uint_as_float(rr[0]) + __uint_as_float(rr[1]); }
    l_reg = l_reg * alpha + ps;
#define PK4(P, B_, OUT) do { unsigned a0 = cvtpk(P[B_+0], P[B_+1]), a1 = cvtpk(P[B_+2], P[B_+3]);                          \
        unsigned b0 = cvtpk(P[B_+4], P[B_+5]), b1 = cvtpk(P[B_+6], P[B_+7]);                                             \
        auto r0 = __builtin_amdgcn_permlane32_swap(a0, b0, false, false); auto r1 = __builtin_amdgcn_permlane32_swap(a1, b1, false, false); \
        u32x4 w = {r0[0], r1[0], r0[1], r1[1]}; OUT = *reinterpret_cast<bf16x8*>(&w); } while (0)
    PK4(p0, 0, pa0); PK4(p0, 8, pa1); PK4(p1, 0, pa2); PK4(p1, 8, pa3);
#undef PK4
}
template <int KB>
__device__ __forceinline__ void qkt(f32x16& p0, f32x16& p1, const char* K_lds, const float* B_lds, int r32, int hi, const bf16x8* qr) {
    const float* bl = B_lds + KB * 64 + 4 * hi;
#pragma unroll
    for (int g = 0; g < 4; ++g) { const f32x4 t = *(const f32x4*)(bl + 8 * g), u = *(const f32x4*)(bl + 32 + 8 * g);
        p0[4 * g + 0] = t.x; p0[4 * g + 1] = t.y; p0[4 * g + 2] = t.z; p0[4 * g + 3] = t.w; p1[4 * g + 0] = u.x; p1[4 * g + 1] = u.y; p1[4 * g + 2] = u.z; p1[4 * g + 3] = u.w; }
    const char* kb[4];
#pragma unroll
    for (int dd = 0; dd < 4; ++dd) kb[dd] = K_lds + KB * SHM_K + KSWZ(r32, (dd * 16 + hi * 8) * 2);
#pragma unroll
    for (int d0 = 0; d0 < 8; ++d0) { const char* a = kb[d0 & 3] + (d0 >> 2) * 128;
        bf16x8 b0 = *reinterpret_cast<const bf16x8*>(a);
        bf16x8 b1 = *reinterpret_cast<const bf16x8*>(a + 32 * 256);
        p0 = __builtin_amdgcn_mfma_f32_32x32x16_bf16(b0, qr[d0], p0, 0, 0, 0);
        p1 = __builtin_amdgcn_mfma_f32_32x32x16_bf16(b1, qr[d0], p1, 0, 0, 0); }
}
template <int VB>
__device__ __forceinline__ void pv_tile(f32x16* o, int vb0, bf16x8 pa0, bf16x8 pa1, bf16x8 pa2, bf16x8 pa3) {
#define TRRD(dst, off) asm volatile("ds_read_b64_tr_b16 %0, %1 offset:%2" : "=&v"(dst) : "v"(vb0), "i"(off) : "memory")
#define PV_D0(d0) do { s16x4 l0, l1, l2, l3, h0, h1, h2, h3; constexpr int b_ = VB * SHM_V + v_rd_off(d0, 0, 0); \
        TRRD(l0, b_); TRRD(h0, b_ + 2048); TRRD(l1, b_ + 4096); TRRD(h1, b_ + 6144); TRRD(l2, b_ + 8192); TRRD(h2, b_ + 10240); TRRD(l3, b_ + 12288); TRRD(h3, b_ + 14336); \
        asm volatile("s_waitcnt lgkmcnt(0)" ::: "memory"); SBAR();   \
        o[d0] = __builtin_amdgcn_mfma_f32_32x32x16_bf16(pa0, (bf16x8){l0[0], l0[1], l0[2], l0[3], h0[0], h0[1], h0[2], h0[3]}, o[d0], 0, 0, 0);   \
        o[d0] = __builtin_amdgcn_mfma_f32_32x32x16_bf16(pa1, (bf16x8){l1[0], l1[1], l1[2], l1[3], h1[0], h1[1], h1[2], h1[3]}, o[d0], 0, 0, 0);   \
        o[d0] = __builtin_amdgcn_mfma_f32_32x32x16_bf16(pa2, (bf16x8){l2[0], l2[1], l2[2], l2[3], h2[0], h2[1], h2[2], h2[3]}, o[d0], 0, 0, 0);   \
        o[d0] = __builtin_amdgcn_mfma_f32_32x32x16_bf16(pa3, (bf16x8){l3[0], l3[1], l3[2], l3[3], h3[0], h3[1], h3[2], h3[3]}, o[d0], 0, 0, 0); } while (0)
    PV_D0(0); PV_D0(1); PV_D0(2); PV_D0(3);
#undef PV_D0
#undef TRRD
}
struct BlockRef { const bf16* KV; bf16* O; const float* Bz; int P0; };
struct Seam { bf16x8 qr[8]; bf16x8 st_v0, st_v1, st_k0, st_k1; float st_b; };
#define VMW() asm volatile("s_waitcnt vmcnt(0)" ::: "memory")
#define VMWN(n) asm volatile("s_waitcnt vmcnt(%0)" :: "i"(n) : "memory")
#define LD8(R, so) __builtin_bit_cast(bf16x8, __builtin_amdgcn_raw_buffer_load_b128(R, voff, (so), 0))
#define SLOAD_H(R, BR, k0) do { const unsigned so_ = (unsigned)(k0) * (PITCH * 2u); \
                         S.st_v0 = LD8(R, so_ + VOFF); S.st_v1 = LD8(R, so_ + VOFF + 32u * PITCH * 2u); \
                         S.st_k0 = LD8(R, so_ + KOFF); S.st_k1 = LD8(R, so_ + KOFF + 32u * PITCH * 2u); \
                         S.st_b = __builtin_bit_cast(float, __builtin_amdgcn_raw_buffer_load_b32(BR, (unsigned)(tid & 63) * 4u, (unsigned)(k0) * 4u, 0)); } while (0)
#define QLOAD(R, P0_) do { const unsigned qso_ = (unsigned)((P0_) + wid * QBLK) * (PITCH * 2u); _Pragma("unroll") for (int d0 = 0; d0 < 8; ++d0) \
                         S.qr[d0] = __builtin_bit_cast(bf16x8, __builtin_amdgcn_raw_buffer_load_b128(R, qvoff, qso_ + d0 * 32, 0)); } while (0)
#define MKRS(ref) __builtin_amdgcn_make_buffer_rsrc((void*)(ref).KV, 0, (unsigned)((size_t)T * NQKV * 2), 0x00020000)
#define MKBRS(ref) __builtin_amdgcn_make_buffer_rsrc((void*)(ref).Bz, 0, T * 4, 0x00020000)
#define SWRITE_HK(bf) do { *(bf16x8*)(K_lds + (bf) * SHM_K + kws) = S.st_k0; *(bf16x8*)(K_lds + (bf) * SHM_K + kws + 32 * 256) = S.st_k1; if (tid < 64) B_lds[(bf) * 64 + tid] = S.st_b; } while (0)
#define SWRITE_HV(bf) do { *(bf16x8*)(V_lds + (bf) * SHM_V + vst0) = S.st_v0; *(bf16x8*)(V_lds + (bf) * SHM_V + vst1) = S.st_v1; } while (0)
#define SWRITE_H(bf) do { SWRITE_HV(bf); SWRITE_HK(bf); } while (0)
__device__ __forceinline__ void prime(const BlockRef& cur, char* lds, Seam& S) {
    const int tid = threadIdx.x, wid = __builtin_amdgcn_readfirstlane(tid >> 6), lane = tid & 63, r32 = lane & 31, hi = lane >> 5;
    const int sr = tid >> 4, sc = (tid & 15) * 8, kws = KSWZ(sr, sc * 2); char* K_lds = lds + 2 * SHM_V; float* B_lds = (float*)(lds + BIAS_OFF);
    const unsigned voff = (unsigned)(sr * PITCH + sc) * 2u, qvoff = (unsigned)(r32 * PITCH + hi * 8) * 2u;
    const __amdgpu_buffer_rsrc_t rs = MKRS(cur), brs = MKBRS(cur);
    QLOAD(rs, cur.P0);
    SLOAD_H(rs, brs, 0); VMW(); SWRITE_HK(0);
    __syncthreads();
}
__device__ __forceinline__ void block(const BlockRef& cur, const BlockRef& nxt, char* lds, Seam& S) {
    const int tid = threadIdx.x, wid = __builtin_amdgcn_readfirstlane(tid >> 6), lane = tid & 63, r32 = lane & 31, hi = lane >> 5;
    const int W = T;
    const int j_hi = (cur.P0 + QB - 1) / KVBLK + 1;
    const int NT = j_hi;
    const int kbn = 0;
    const int qlo = cur.P0 + wid * QBLK, qm = qlo + r32 - 4 * hi;
    char* V_lds = lds; char* K_lds = lds + 2 * SHM_V; float* B_lds = (float*)(lds + BIAS_OFF);
    float* ws = (float*)(lds + WS_OFF) + wid * 64; float* li_l = ws, * al_l = ws + 32;
    float m_reg = -1e30f, l_reg = 0; f32x16 o[4] = {};
    const int sr = tid >> 4, sc = (tid & 15) * 8, vst0 = v_st(sr, sc), vst1 = v_st(32 + sr, sc), kws = KSWZ(sr, sc * 2);
    const int vb0 = (int)(uintptr_t)V_lds + v_rd_base(lane);
    const unsigned voff = (unsigned)(sr * PITCH + sc) * 2u, qvoff = (unsigned)(r32 * PITCH + hi * 8) * 2u;
    const __amdgpu_buffer_rsrc_t rs = MKRS(cur), brs = MKBRS(cur);
#define RESC(a) do { if (__any((a) < 1.f)) { if (hi == 0) al_l[r32] = (a); asm volatile("s_waitcnt lgkmcnt(0)" ::: "memory");              \
                     for (int d_ = 0; d_ < 4; ++d_) for (int r = 0; r < 16; ++r) o[d_][r] *= al_l[crow(r, hi)]; } } while (0)
#define KBASE(t) ((t) * KVBLK)
#define MASKT(P0_, P1_, t) do { const int kb_ = KBASE(t); if (kb_ + KVBLK - 1 > qlo) mask_tile(P0_, P1_, qm - kb_, (unsigned)W); } while (0)
    constexpr int NQL = 8;
#define SEAM_K0() do { VMWN(NQL); SWRITE_HK(0); SBAR(); } while (0)
    f32x16 pA0, pA1, pB0, pB1; float mnA, mnB, alA, alB; bf16x8 pa0, pa1, pa2, pa3;
    SWRITE_HV(0); SBAR();
    if (NT > 1) { SLOAD_H(rs, brs, KBASE(1)); }
    SBAR(); qkt<0>(pA0, pA1, K_lds, B_lds, r32, hi, S.qr);
    MASKT(pA0, pA1, 0); partialSM(pA0, pA1, m_reg, mnA, alA);
    if (NT > 1) { VMW(); SWRITE_H(1); }
    __syncthreads();
#define HALF_STEP(PX0, PX1, mnX, alX, PY0, PY1, alY, t, KB, VB, SB) do {                                                      \
        SBAR(); qkt<KB>(PX0, PX1, K_lds, B_lds, r32, hi, S.qr);                                             \
        finishSM(PY0, PY1, alY, l_reg, pa0, pa1, pa2, pa3); SBAR();                                                           \
        if ((t) + 1 < NT) { SLOAD_H(rs, brs, KBASE((t) + 1)); SBAR(); }                                               \
        pv_tile<VB>(o, vb0, pa0, pa1, pa2, pa3); MASKT(PX0, PX1, (t)); partialSM(PX0, PX1, m_reg, mnX, alX);                                        \
        __syncthreads();                                                                                                      \
        if ((t) + 1 < NT) { VMW(); SWRITE_H(SB); }                                                                          \
        RESC(alX); __syncthreads(); } while (0)
    for (int t = 1; t + 1 < NT; t += 2) {
        HALF_STEP(pB0, pB1, mnB, alB, pA0, pA1, alA, t, 1, 0, 0);
        HALF_STEP(pA0, pA1, mnA, alA, pB0, pB1, alB, t + 1, 0, 1, 1);
    }
    const bool even = (NT & 1) == 0;
    if (even) { SBAR(); qkt<1>(pB0, pB1, K_lds, B_lds, r32, hi, S.qr); SBAR(); }
    { const __amdgpu_buffer_rsrc_t nrs = MKRS(nxt), nbrs = MKBRS(nxt);
      SLOAD_H(nrs, nbrs, kbn); SBAR();
      QLOAD(nrs, nxt.P0); }
    SBAR();
    finishSM(pA0, pA1, alA, l_reg, pa0, pa1, pa2, pa3); SBAR();
    pv_tile<0>(o, vb0, pa0, pa1, pa2, pa3);
    if (even) { MASKT(pB0, pB1, NT - 1); partialSM(pB0, pB1, m_reg, mnB, alB); __syncthreads(); RESC(alB);
        finishSM(pB0, pB1, alB, l_reg, pa0, pa1, pa2, pa3); SBAR(); pv_tile<1>(o, vb0, pa0, pa1, pa2, pa3); }
    SBAR(); SEAM_K0();
    if (hi == 0) li_l[r32] = l_reg; asm volatile("s_waitcnt lgkmcnt(0)" ::: "memory");
    float rli[16];
#pragma unroll
    for (int r = 0; r < 16; ++r) rli[r] = __builtin_amdgcn_rcpf(li_l[crow(r, hi)]);
    bf16* Ow = cur.O + (size_t)(wid * QBLK) * OPITCH;
#pragma unroll
    for (int r = 0; r < 16; ++r) { const int orow = crow(r, hi);
#pragma unroll
        for (int d0 = 0; d0 < 4; ++d0) { const float v = o[d0][r] * rli[r];
            const float vn = __shfl_xor(v, 1);
            const unsigned pk_ = cvtpk(v, vn), pk2_ = (unsigned)__shfl_xor((int)pk_, 2);
            if ((r32 & 3) == 0) { v2u w_; w_.x = pk_; w_.y = pk2_; *(v2u*)(Ow + (size_t)orow * OPITCH + d0 * 32 + r32) = w_; } } }
    __syncthreads();
#undef RESC
#undef KBASE
#undef MASKT
#undef SEAM_K0
#undef HALF_STEP
}
#undef VMW
#undef VMWN
#undef LD8
#undef QLOAD
#undef MKRS
#undef MKBRS
#undef SLOAD_H
#undef SWRITE_HK
#undef SWRITE_HV
#undef SWRITE_H
__device__ __forceinline__ BlockRef make_ref(const bf16* QKV, const float* CB, bf16* O, int h, int qb) {
    BlockRef r; r.KV = QKV + (size_t)h * T * D; r.O = O + (size_t)(qb * QB) * OPITCH + h * D; r.Bz = CB + (size_t)h * T; r.P0 = qb * QB; return r;
}
__device__ __forceinline__ void phase(char* lds, const bf16* QKV, const float* CB, bf16* O, int first, int stride) {
    constexpr int NQB = T / QB, NX = NQB / 2, TOTAL = FOX_H * NX;
    int L = first; if (L >= TOTAL) return;
    int pass = 0;
    BlockRef cur = make_ref(QKV, CB, O, L / NX, L % NX);
    Seam S;
    prime(cur, lds, S);
    for (;;) {
        const bool more_pass = pass == 0, more_item = L + stride < TOTAL, last = !more_pass && !more_item;
        int Ln = L, passn = pass + 1;
        if (!more_pass) { passn = 0; Ln = more_item ? L + stride : L; }
        const int hn = Ln / NX, xn = Ln % NX;
        const BlockRef nxt = last ? cur : make_ref(QKV, CB, O, hn, passn ? NQB - 1 - xn : xn);
        block(cur, nxt, lds, S);
        if (last) break;
        cur = nxt; pass = passn; L = Ln;
    }
}
#undef KSWZ
#undef SBAR
}


struct GlaBufs { bf16* QT; bf16* KT; bf16* QI; bf16* KET; bf16* VT; float* DL; bf16* OI; float* SE; float* PE; bf16* OI2; bf16* S0T; float* DPOS; };
constexpr int GLA_G = 16, GLA_GC = GLA_NCH / GLA_G;
__device__ __forceinline__ void gla_prep(Frame& F, const bf16* QKV, const float* GLOW, const float* w_up, const float* b_gate, const GlaBufs& B) {
    LAS float* glow_s = (LAS float*)(F.lds);
    LAS float* bcum = (LAS float*)(F.lds + 4096);
    LAS unsigned char* keR = F.lds + 69632;
    LAS unsigned char* vR = F.lds + 106496;
    const int tid = F.tid, c = tid & 255, half = tid >> 8, lane = F.lane;
    const int tr_rd = (8 * (lane >> 5) + ((lane >> 2) & 3)) * 576 + (16 * ((lane >> 4) & 1) + 4 * (lane & 3)) * 2;
    const int tr_col = 16 * ((lane >> 4) & 1) + (lane & 15), tr_tok = 8 * (lane >> 5);
    for (int unit = F.vcu; unit < GLA_NCH * GLA_H; unit += F.G) {
        const int n = unit >> 2, h = unit & 3, t0 = n * GLA_C;
        __syncthreads();
        if (tid < 256) *((LAS f32x4*)glow_s + tid) = *((const f32x4*)(GLOW + (size_t)t0 * 16) + tid);
        float w[16];
#pragma unroll
        for (int r = 0; r < 16; ++r) w[r] = w_up[r * 1024 + h * 256 + c];
        const float bg = b_gate[h * 256 + c];
        v4u qv[4], kv[4], vv[2][4];
#pragma unroll
        for (int it = 0; it < 4; ++it) { const int id = tid + 512 * it, t = id >> 5, c8 = (id & 31) * 8; const size_t ro = (size_t)(t0 + t) * NQKV + h * 256 + c8;
            qv[it] = *(const v4u*)(QKV + ro); kv[it] = *(const v4u*)(QKV + ro + 1024); }
#pragma unroll
        for (int hv = 0; hv < 2; ++hv)
#pragma unroll
            for (int it = 0; it < 4; ++it) { const int id = tid + 512 * it, t = id >> 5, d8 = (id & 31) * 8; vv[hv][it] = *(const v4u*)(QKV + (size_t)(t0 + t) * NQKV + 2048 + h * 512 + hv * 256 + d8); }
        __syncthreads();
        { float cum = 0.f;
#pragma unroll 4
          for (int i = 0; i < 32; ++i) { const int t = half * 32 + i; float z = bg;
              const LAS f32x4* gp = (const LAS f32x4*)(glow_s + t * 16);
#pragma unroll
              for (int q = 0; q < 4; ++q) { const f32x4 g4 = gp[q]; z += g4.x * w[4 * q] + g4.y * w[4 * q + 1] + g4.z * w[4 * q + 2] + g4.w * w[4 * q + 3]; }
              const float ls = z >= 0.f ? -__logf(1.f + __expf(-z)) : z - __logf(1.f + __expf(z));
              cum += ls * (1.f / 16.f); bcum[t * 256 + c] = cum; } }
        __syncthreads();
        if (half == 1) { const float add = bcum[31 * 256 + c];
#pragma unroll 4
            for (int i = 0; i < 32; ++i) bcum[(32 + i) * 256 + c] += add; }
        __syncthreads();
        if (half == 0) B.DL[(size_t)(h * GLA_NCH + n) * 256 + c] = __expf(bcum[63 * 256 + c]);
#pragma unroll
        for (int it = 0; it < 4; ++it) {
            const int id = tid + 512 * it, t = id >> 5, c8 = (id & 31) * 8;
            float bb[8], br_[8], bl[8];
            { const f32x4 a0_ = *(const LAS f32x4*)(bcum + t * 256 + c8), a1_ = *(const LAS f32x4*)(bcum + t * 256 + c8 + 4);
              const f32x4 r0_ = *(const LAS f32x4*)(bcum + 31 * 256 + c8), r1_ = *(const LAS f32x4*)(bcum + 31 * 256 + c8 + 4);
              const f32x4 l0_ = *(const LAS f32x4*)(bcum + 63 * 256 + c8), l1_ = *(const LAS f32x4*)(bcum + 63 * 256 + c8 + 4);
#pragma unroll
              for (int j = 0; j < 4; ++j) { bb[j] = a0_[j]; bb[4 + j] = a1_[j]; br_[j] = r0_[j]; br_[4 + j] = r1_[j]; bl[j] = l0_[j]; bl[4 + j] = l1_[j]; } }
            float qf[8], kf[8];
#pragma unroll
            for (int j = 0; j < 4; ++j) { qf[2 * j] = bflo(qv[it][j]) * 0.0625f; qf[2 * j + 1] = bfhi(qv[it][j]) * 0.0625f; kf[2 * j] = bflo(kv[it][j]); kf[2 * j + 1] = bfhi(kv[it][j]); }
            float qt[8], kt[8], qi[8], ke[8];
#pragma unroll
            for (int j = 0; j < 8; ++j) { const float e1 = __expf(bb[j] - br_[j]), e2 = __expf(bb[j]);
                qt[j] = qf[j] * e1; kt[j] = kf[j] * __builtin_amdgcn_rcpf(e1); qi[j] = qf[j] * e2; ke[j] = kf[j] * __expf(bl[j] - bb[j]); }
            const size_t oo = (size_t)(t0 + t) * 1024 + h * 256;
            { v4u o; o.x = pk2(qt[0], qt[1]); o.y = pk2(qt[2], qt[3]); o.z = pk2(qt[4], qt[5]); o.w = pk2(qt[6], qt[7]); *(v4u*)(B.QT + oo + c8) = o; }
            { v4u o; o.x = pk2(kt[0], kt[1]); o.y = pk2(kt[2], kt[3]); o.z = pk2(kt[4], kt[5]); o.w = pk2(kt[6], kt[7]); *(v4u*)(B.KT + oo + c8) = o; }
            {
                const int kk = c8 & 31, p0 = (c8 & ~31) + 8 * ((kk >> 2) & 3) + 4 * (kk >> 4);
                v2u o0, o1; o0.x = pk2(qi[0], qi[1]); o0.y = pk2(qi[2], qi[3]); o1.x = pk2(qi[4], qi[5]); o1.y = pk2(qi[6], qi[7]);
                *(v2u*)(B.QI + oo + p0) = o0; *(v2u*)(B.QI + oo + p0 + 8) = o1; }
            { v4u o; o.x = pk2(ke[0], ke[1]); o.y = pk2(ke[2], ke[3]); o.z = pk2(ke[4], ke[5]); o.w = pk2(ke[6], ke[7]); *(LAS v4u*)(keR + t * 576 + c8 * 2) = o; }
        }
#pragma unroll
        for (int it = 0; it < 4; ++it) { const int id = tid + 512 * it, t = id >> 5, d8 = (id & 31) * 8; *(LAS v4u*)(vR + t * 576 + d8 * 2) = vv[0][it]; }
        __syncthreads();
#define GP_TROUT(SRC, DST) do { _Pragma("unroll") for (int st = 0; st < 4; ++st) { const int step = F.wave * 4 + st, cb = (step >> 2) * 32, tb = (step & 3) * 16; \
            const s16x4 l_ = lds_tr16((SRC) + tb * 576 + cb * 2 + tr_rd), h_ = lds_tr16((SRC) + (tb + 4) * 576 + cb * 2 + tr_rd); \
            *(bf16x8*)((DST) + (size_t)(cb + tr_col) * 64 + tb + tr_tok) = (bf16x8){l_[0], l_[1], l_[2], l_[3], h_[0], h_[1], h_[2], h_[3]}; } } while (0)
        GP_TROUT(keR, B.KET + (size_t)(h * GLA_NCH + n) * 256 * 64);
        GP_TROUT(vR, B.VT + (size_t)(h * GLA_NCH + n) * 512 * 64);
        __syncthreads();
#pragma unroll
        for (int it = 0; it < 4; ++it) { const int id = tid + 512 * it, t = id >> 5, d8 = (id & 31) * 8; *(LAS v4u*)(vR + t * 576 + d8 * 2) = vv[1][it]; }
        __syncthreads();
        GP_TROUT(vR, B.VT + ((size_t)(h * GLA_NCH + n) * 512 + 256) * 64);
#undef GP_TROUT
    }
}
constexpr int GS_QI = 0, GS_KET = 64 * 528, GS_DL = GS_KET + 256 * 144, GS_BUF = GS_DL + 1024;
template <bool CORR>
__device__ __forceinline__ void gla_scan(Frame& F, const GlaBufs& B) {
    const int tid = F.tid, lane = F.lane, wid = F.wave, fr = lane & 15, fq = lane >> 4;
    for (int unit = F.vcu; unit < GLA_G * GLA_H * 8; unit += F.G) {
        const int g = unit >> 5, h = (unit >> 3) & 3, sg = unit & 7;
        if (CORR && g == 0) continue;
        const int n0 = g * GLA_GC, n1 = n0 + GLA_GC;
        __syncthreads();
#define GS_BAR() asm volatile("s_waitcnt lgkmcnt(0)\n\ts_barrier" ::: "memory")
        if (wid >= 4) {
            const int lt = tid - 256;
            v4u ra[17], rb[17];
            f32x4 pacc = (f32x4){1.f, 1.f, 1.f, 1.f};
#define GL_LOAD(R, n_) do { const int nn_ = (n_) < n1 ? (n_) : n1 - 1; \
                _Pragma("unroll") for (int i = 0; i < 8; ++i) { const int id = lt + 256 * i; R[i] = *(const v4u*)(B.QI + (size_t)(nn_ * GLA_C + (id >> 5)) * 1024 + h * 256 + (id & 31) * 8); } \
                if (!CORR) { _Pragma("unroll") for (int i = 0; i < 8; ++i) { const int id = lt + 256 * i; R[8 + i] = *(const v4u*)(B.KET + (size_t)(h * GLA_NCH + nn_) * 256 * 64 + (size_t)id * 8); } } \
                R[16] = *(const v4u*)(B.DL + (size_t)(h * GLA_NCH + nn_) * 256 + (lt & 63) * 4); } while (0)
#define GL_WRITE(R, buf) do { LAS unsigned char* bp_ = F.lds + (buf) * GS_BUF; \
                _Pragma("unroll") for (int i = 0; i < 8; ++i) { const int id = lt + 256 * i; *(LAS v4u*)(bp_ + GS_QI + (id >> 5) * 528 + (id & 31) * 16) = R[i]; } \
                if (!CORR) { _Pragma("unroll") for (int i = 0; i < 8; ++i) { const int id = lt + 256 * i; *(LAS v4u*)(bp_ + GS_KET + (id >> 3) * 144 + (id & 7) * 16) = R[8 + i]; } } \
                if (lt < 64) *(LAS v4u*)(bp_ + GS_DL + lt * 16) = R[16]; } while (0)
            GL_LOAD(ra, n0); GL_WRITE(ra, 0); pacc = pacc * __builtin_bit_cast(f32x4, ra[16]); GL_LOAD(ra, n0 + 1); GL_LOAD(rb, n0 + 2);
            GS_BAR();
#pragma unroll 1
            for (int n = n0; n < n1; n += 2) {
                GL_WRITE(ra, 1); pacc = pacc * __builtin_bit_cast(f32x4, ra[16]); GL_LOAD(ra, n + 3);
                GS_BAR();
                GL_WRITE(rb, 0); if (n + 2 < n1) pacc = pacc * __builtin_bit_cast(f32x4, rb[16]); GL_LOAD(rb, n + 4);
                GS_BAR();
            }
            if (!CORR && sg == 0 && lt < 64) *(f32x4*)(B.PE + (size_t)(g * GLA_H + h) * 256 + lt * 4) = pacc;
#undef GL_LOAD
#undef GL_WRITE
        } else {
            const int slice = sg * 4 + wid;
            f32x4 S[16];
#pragma unroll
            for (int i = 0; i < 16; ++i) S[i] = (f32x4){0.f, 0.f, 0.f, 0.f};
            if (CORR) {
                f32x4 pA[8], sA[8], pB[8], sB[8];
#define GC_LOAD(P_, S_, gp_, i0) do { const float* pe = B.PE + (size_t)((gp_) * GLA_H + h) * 256 + 4 * fq; const float* se = B.SE + ((size_t)(((gp_) * GLA_H + h) * 32 + slice) * 16 * 64 + lane) * 4; \
                    _Pragma("unroll") for (int i = 0; i < 8; ++i) { P_[i] = *(const f32x4*)(pe + 16 * ((i0) + i)); S_[i] = *(const f32x4*)(se + (size_t)((i0) + i) * 256); } } while (0)
                GC_LOAD(pA, sA, 0, 0); GC_LOAD(pB, sB, 0, 8);
#pragma unroll 1
                for (int gp = 0; gp < g; ++gp) { const int gq = gp + 1 < g ? gp + 1 : gp;
#pragma unroll
                    for (int i = 0; i < 8; ++i) S[i] = S[i] * pA[i] + sA[i];
                    GC_LOAD(pA, sA, gq, 0);
#pragma unroll
                    for (int i = 0; i < 8; ++i) S[8 + i] = S[8 + i] * pB[i] + sB[i];
                    GC_LOAD(pB, sB, gq, 8);
                }
#undef GC_LOAD
            }
            const bf16* vtp = B.VT + ((size_t)(h * GLA_NCH) * 512 + slice * 16 + fr) * 64 + 8 * fq;
            bf16x8 vn0 = *(const bf16x8*)(vtp + (size_t)n0 * 512 * 64), vn1 = *(const bf16x8*)(vtp + (size_t)n0 * 512 * 64 + 32);
            bf16* const OO = CORR ? B.OI2 : B.OI;
            GS_BAR();
#pragma unroll 1
            for (int n = n0; n < n1; ++n) {
                const LAS unsigned char* bp = F.lds + ((n - n0) & 1) * GS_BUF;
                const bf16x8 v0 = vn0, v1 = vn1;
                if (!CORR) { const int nn = n + 1 < n1 ? n + 1 : n; vn0 = *(const bf16x8*)(vtp + (size_t)nn * 512 * 64); vn1 = *(const bf16x8*)(vtp + (size_t)nn * 512 * 64 + 32); }
                bf16x8 Sb[8];
#pragma unroll
                for (int s = 0; s < 8; ++s) { v4u wv; wv.x = pk2(S[2 * s].x, S[2 * s].y); wv.y = pk2(S[2 * s].z, S[2 * s].w); wv.z = pk2(S[2 * s + 1].x, S[2 * s + 1].y); wv.w = pk2(S[2 * s + 1].z, S[2 * s + 1].w); Sb[s] = __builtin_bit_cast(bf16x8, wv); }
                f32x4 oacc[4];
#pragma unroll
                for (int m = 0; m < 4; ++m) oacc[m] = (f32x4){0.f, 0.f, 0.f, 0.f};
#define GS_SB() __builtin_amdgcn_sched_barrier(0)
#define GS_LQ(R, s0) do { _Pragma("unroll") for (int m = 0; m < 4; ++m) R[m] = *(const LAS bf16x8*)(bp + GS_QI + (16 * m + fr) * 528 + (s0) * 64 + fq * 16); } while (0)
#define GS_MM(R, s0) do { _Pragma("unroll") for (int m = 0; m < 4; ++m) oacc[m] = __builtin_amdgcn_mfma_f32_16x16x32_bf16(Sb[(s0)], R[m], oacc[m], 0, 0, 0); } while (0)
                {   bf16x8 qa[4], qb[4], qc[4];
                    GS_LQ(qa, 0); GS_LQ(qb, 1); GS_LQ(qc, 2); GS_SB();
                    GS_MM(qa, 0); GS_SB(); GS_LQ(qa, 3); GS_SB();
                    GS_MM(qb, 1); GS_SB(); GS_LQ(qb, 4); GS_SB();
                    GS_MM(qc, 2); GS_SB(); GS_LQ(qc, 5); GS_SB();
                    GS_MM(qa, 3); GS_SB(); GS_LQ(qa, 6); GS_SB();
                    GS_MM(qb, 4); GS_SB(); GS_LQ(qb, 7); GS_SB();
                    GS_MM(qc, 5); GS_SB();
                    GS_MM(qa, 6); GS_MM(qb, 7); GS_SB(); }
#pragma unroll
                for (int m = 0; m < 4; ++m) { v2u ov; ov.x = pk2(oacc[m].x, oacc[m].y); ov.y = pk2(oacc[m].z, oacc[m].w); *(v2u*)(OO + (size_t)(n * GLA_C + 16 * m + fr) * DM + h * 512 + slice * 16 + 4 * fq) = ov; }
                if (CORR) {
#pragma unroll
                    for (int i = 0; i < 16; ++i) S[i] = S[i] * *(const LAS f32x4*)(bp + GS_DL + (16 * i + 4 * fq) * 4);
                } else {
#define GS_LK(R, D_, i0) do { _Pragma("unroll") for (int ii = 0; ii < 2; ++ii) { D_[ii] = *(const LAS f32x4*)(bp + GS_DL + (16 * ((i0) + ii) + 4 * fq) * 4); \
                    R[2 * ii] = *(const LAS bf16x8*)(bp + GS_KET + (16 * ((i0) + ii) + fr) * 144 + fq * 16); R[2 * ii + 1] = *(const LAS bf16x8*)(bp + GS_KET + (16 * ((i0) + ii) + fr) * 144 + 64 + fq * 16); } } while (0)
#define GS_UP(R, D_, i0) do { _Pragma("unroll") for (int ii = 0; ii < 2; ++ii) { S[(i0) + ii] = S[(i0) + ii] * D_[ii]; \
                    S[(i0) + ii] = __builtin_amdgcn_mfma_f32_16x16x32_bf16(R[2 * ii], v0, S[(i0) + ii], 0, 0, 0); S[(i0) + ii] = __builtin_amdgcn_mfma_f32_16x16x32_bf16(R[2 * ii + 1], v1, S[(i0) + ii], 0, 0, 0); } } while (0)
                {   bf16x8 ka[4], kb[4], kc[4]; f32x4 da[2], db[2], dc[2];
                    GS_LK(ka, da, 0); GS_LK(kb, db, 2); GS_LK(kc, dc, 4); GS_SB();
                    GS_UP(ka, da, 0); GS_SB(); GS_LK(ka, da, 6); GS_SB();
                    GS_UP(kb, db, 2); GS_SB(); GS_LK(kb, db, 8); GS_SB();
                    GS_UP(kc, dc, 4); GS_SB(); GS_LK(kc, dc, 10); GS_SB();
                    GS_UP(ka, da, 6); GS_SB(); GS_LK(ka, da, 12); GS_SB();
                    GS_UP(kb, db, 8); GS_SB(); GS_LK(kb, db, 14); GS_SB();
                    GS_UP(kc, dc, 10); GS_SB();
                    GS_UP(ka, da, 12); GS_UP(kb, db, 14); GS_SB(); }
#undef GS_LK
#undef GS_UP
                }
#undef GS_SB
#undef GS_LQ
#undef GS_MM
                GS_BAR();
            }
            if (!CORR) {
                float* se = B.SE + ((size_t)((g * GLA_H + h) * 32 + slice) * 16 * 64 + lane) * 4;
#pragma unroll
                for (int i = 0; i < 16; ++i) *(f32x4*)(se + (size_t)i * 256) = S[i];
            }
        }
#undef GS_BAR
    }
}
__device__ __forceinline__ void glds16(const void* gsrc, unsigned lds_dst) { unsigned keep;
    asm volatile("s_mov_b32 %0, m0\n\ts_mov_b32 m0, %2\n\ts_nop 0\n\tglobal_load_lds_dwordx4 %1, off\n\ts_mov_b32 m0, %0" : "=&s"(keep) : "v"(gsrc), "s"(lds_dst) : "memory"); }
constexpr int GS2_QI = 0, GS2_KET = 32 * 1056, GS2_DL = GS2_KET + 32 * 1088, GS2_BUF = GS2_DL + 1024;
__device__ __forceinline__ void gla_scan8(Frame& F, const GlaBufs& B) {
    const int lane = F.lane, wid = F.wave, fr = lane & 15, fq = lane >> 4;
    const unsigned lds0 = (unsigned)(size_t)F.lds;
    const int qrd = (fr >> 1) * 1056 + (fr & 1) * 512 + (fq ^ (fr & 1)) * 16;
    const int krd = (fr >> 3) * 1088 + (fr & 7) * 128 + (fq ^ ((fr & 7) >> 1)) * 16;
    for (int unit = F.vcu; unit < GLA_G * GLA_H * 4; unit += F.G) {
        const int g = unit >> 4, h = (unit >> 2) & 3, slice = (unit & 3) * 8 + wid;
        const int n0 = g * GLA_GC, n1 = n0 + GLA_GC;
        __syncthreads();
#define GS_BAR() asm volatile("s_waitcnt lgkmcnt(0)\n\ts_barrier" ::: "memory")
#define GS8_DMA(n_, b_) do { const int nn_ = (n_) < n1 ? (n_) : n1 - 1; const unsigned lb_ = lds0 + (b_) * GS2_BUF; \
            _Pragma("unroll") for (int i = 0; i < 4; ++i) { const int pc = wid + 8 * i, rl = lane >> 5, row = 2 * pc + rl, c = (lane & 31) ^ rl; \
                glds16(B.QI + (size_t)(nn_ * GLA_C + row) * 1024 + h * 256 + c * 8, (unsigned)__builtin_amdgcn_readfirstlane((int)(lb_ + GS2_QI + pc * 1056))); } \
            _Pragma("unroll") for (int i = 0; i < 4; ++i) { const int pc = wid + 8 * i, rl = lane >> 3, row = 8 * pc + rl, c = (lane & 7) ^ (rl >> 1); \
                glds16(B.KET + (size_t)(h * GLA_NCH + nn_) * 256 * 64 + row * 64 + c * 8, (unsigned)__builtin_amdgcn_readfirstlane((int)(lb_ + GS2_KET + pc * 1088))); } \
            if (wid == 0) glds16(B.DL + (size_t)(h * GLA_NCH + nn_) * 256 + lane * 4, (unsigned)__builtin_amdgcn_readfirstlane((int)(lb_ + GS2_DL))); } while (0)
        f32x4 S[16];
#pragma unroll
        for (int i = 0; i < 16; ++i) S[i] = (f32x4){0.f, 0.f, 0.f, 0.f};
        f32x4 pacc = (f32x4){1.f, 1.f, 1.f, 1.f};
        GS8_DMA(n0, 0);
        const bf16* vtp = B.VT + ((size_t)(h * GLA_NCH) * 512 + slice * 16 + fr) * 64 + 8 * fq;
        bf16x8 vn0 = *(const bf16x8*)(vtp + (size_t)n0 * 512 * 64), vn1 = *(const bf16x8*)(vtp + (size_t)n0 * 512 * 64 + 32);
        asm volatile("s_waitcnt vmcnt(0)" ::: "memory");
        GS_BAR();
#pragma unroll 1
        for (int n = n0; n < n1; ++n) {
            const int bsel = (n - n0) & 1;
            GS8_DMA(n + 1, bsel ^ 1);
            const LAS unsigned char* bp = F.lds + bsel * GS2_BUF;
            const bf16x8 v0 = vn0, v1 = vn1;
            { const int nn = n + 1 < n1 ? n + 1 : n; vn0 = *(const bf16x8*)(vtp + (size_t)nn * 512 * 64); vn1 = *(const bf16x8*)(vtp + (size_t)nn * 512 * 64 + 32); }
            bf16x8 Sb[8];
#pragma unroll
            for (int s = 0; s < 8; ++s) { v4u wv; wv.x = pk2(S[2 * s].x, S[2 * s].y); wv.y = pk2(S[2 * s].z, S[2 * s].w); wv.z = pk2(S[2 * s + 1].x, S[2 * s + 1].y); wv.w = pk2(S[2 * s + 1].z, S[2 * s + 1].w); Sb[s] = __builtin_bit_cast(bf16x8, wv); }
            f32x4 oacc[4];
#pragma unroll
            for (int m = 0; m < 4; ++m) oacc[m] = (f32x4){0.f, 0.f, 0.f, 0.f};
#define GS_SB() __builtin_amdgcn_sched_barrier(0)
#define GS_LQ(R, s0) do { _Pragma("unroll") for (int m = 0; m < 4; ++m) R[m] = *(const LAS bf16x8*)(bp + GS2_QI + qrd + m * 8448 + (s0) * 64); } while (0)
#define GS_MM(R, s0) do { _Pragma("unroll") for (int m = 0; m < 4; ++m) oacc[m] = __builtin_amdgcn_mfma_f32_16x16x32_bf16(Sb[(s0)], R[m], oacc[m], 0, 0, 0); } while (0)
            {   bf16x8 qa[4], qb[4], qc[4];
                GS_LQ(qa, 0); GS_LQ(qb, 1); GS_LQ(qc, 2); GS_SB();
                GS_MM(qa, 0); GS_SB(); GS_LQ(qa, 3); GS_SB();
                GS_MM(qb, 1); GS_SB(); GS_LQ(qb, 4); GS_SB();
                GS_MM(qc, 2); GS_SB(); GS_LQ(qc, 5); GS_SB();
                GS_MM(qa, 3); GS_SB(); GS_LQ(qa, 6); GS_SB();
                GS_MM(qb, 4); GS_SB(); GS_LQ(qb, 7); GS_SB();
                GS_MM(qc, 5); GS_SB();
                GS_MM(qa, 6); GS_MM(qb, 7); GS_SB(); }
#pragma unroll
            for (int m = 0; m < 4; ++m) { v2u ov; ov.x = pk2(oacc[m].x, oacc[m].y); ov.y = pk2(oacc[m].z, oacc[m].w); *(v2u*)(B.OI + ((((size_t)(n * GLA_H + h) * 32 + slice) * 4 + m) * 64 + lane) * 4) = ov; }
#define GS_LK(R, D_, i0) do { _Pragma("unroll") for (int ii = 0; ii < 2; ++ii) { D_[ii] = *(const LAS f32x4*)(bp + GS2_DL + (16 * ((i0) + ii) + 4 * fq) * 4); \
                R[2 * ii] = *(const LAS bf16x8*)(bp + GS2_KET + krd + ((i0) + ii) * 2176); R[2 * ii + 1] = *(const LAS bf16x8*)(bp + GS2_KET + krd + ((i0) + ii) * 2176 + 64); } } while (0)
#define GS_UP(R, D_, i0) do { _Pragma("unroll") for (int ii = 0; ii < 2; ++ii) { S[(i0) + ii] = S[(i0) + ii] * D_[ii]; \
                S[(i0) + ii] = __builtin_amdgcn_mfma_f32_16x16x32_bf16(R[2 * ii], v0, S[(i0) + ii], 0, 0, 0); S[(i0) + ii] = __builtin_amdgcn_mfma_f32_16x16x32_bf16(R[2 * ii + 1], v1, S[(i0) + ii], 0, 0, 0); } } while (0)
            {   bf16x8 ka[4], kb[4], kc[4]; f32x4 da[2], db[2], dc[2];
                GS_LK(ka, da, 0); GS_LK(kb, db, 2); GS_LK(kc, dc, 4); GS_SB();
                GS_UP(ka, da, 0); GS_SB(); GS_LK(ka, da, 6); GS_SB();
                GS_UP(kb, db, 2); GS_SB(); GS_LK(kb, db, 8); GS_SB();
                GS_UP(kc, dc, 4); GS_SB(); GS_LK(kc, dc, 10); GS_SB();
                GS_UP(ka, da, 6); GS_SB(); GS_LK(ka, da, 12); GS_SB();
                GS_UP(kb, db, 8); GS_SB(); GS_LK(kb, db, 14); GS_SB();
                GS_UP(kc, dc, 10); GS_SB();
                GS_UP(ka, da, 12); GS_UP(kb, db, 14); GS_SB(); }
            if (wid == 0) pacc = pacc * *(const LAS f32x4*)(bp + GS2_DL + lane * 16);
#undef GS_LK
#undef GS_UP
#undef GS_SB
#undef GS_LQ
#undef GS_MM
            asm volatile("s_waitcnt vmcnt(0)" ::: "memory");
            GS_BAR();
        }
        {   float* se = B.SE + ((size_t)((g * GLA_H + h) * 32 + slice) * 16 * 64 + lane) * 4;
#pragma unroll
            for (int i = 0; i < 16; ++i) *(f32x4*)(se + (size_t)i * 256) = S[i]; }
        if ((unit & 3) == 0 && wid == 0) *(f32x4*)(B.PE + (size_t)(g * GLA_H + h) * 256 + lane * 4) = pacc;
#undef GS8_DMA
#undef GS_BAR
    }
}
__device__ __forceinline__ void gla_fold(Frame& F, const GlaBufs& B) {
    const int lane = F.lane, fr = lane & 15, fq = lane >> 4;
    const int wu = F.vcu + F.G * F.wave;
    if (wu < GLA_H * 32 * 4) {
        const int h = wu >> 7, slice = (wu >> 2) & 31, quad = wu & 3;
        f32x4 S[4], P[3][4], E[3][4];
#pragma unroll
        for (int j = 0; j < 4; ++j) S[j] = (f32x4){0.f, 0.f, 0.f, 0.f};
#define GF_LOAD(r_, gp_) do { const float* pe = B.PE + (size_t)((gp_) * GLA_H + h) * 256 + 4 * fq + 64 * quad; const float* se = B.SE + ((size_t)(((gp_) * GLA_H + h) * 32 + slice) * 16 * 64 + lane) * 4 + (size_t)quad * 1024; \
            _Pragma("unroll") for (int j = 0; j < 4; ++j) { P[r_][j] = *(const f32x4*)(pe + 16 * j); E[r_][j] = *(const f32x4*)(se + (size_t)j * 256); } } while (0)
        GF_LOAD(0, 0); GF_LOAD(1, 1); GF_LOAD(2, 2);
#pragma unroll
        for (int gp = 0; gp < GLA_G - 1; ++gp) {
#pragma unroll
            for (int j = 0; j < 4; ++j) S[j] = S[j] * P[gp % 3][j] + E[gp % 3][j];
            if (gp + 3 < GLA_G - 1) GF_LOAD(gp % 3, gp + 3);
            const int dv_ = slice * 16 + fr, wv_ = dv_ >> 6, r5_ = dv_ & 31, nn_ = 2 * ((dv_ >> 5) & 1) + ((r5_ >> 2) & 1), fo_ = 4 * (r5_ >> 3) + (r5_ & 3);
            bf16* so = B.S0T + (size_t)(gp * GLA_H + h) * 512 * 256 + ((size_t)((wv_ * 4 + nn_) * 8 + 2 * quad) * 64 + fq * 16 + fo_) * 8;
#pragma unroll
            for (int s2 = 0; s2 < 2; ++s2) { v4u wv; wv.x = pk2(S[2 * s2].x, S[2 * s2].y); wv.y = pk2(S[2 * s2].z, S[2 * s2].w); wv.z = pk2(S[2 * s2 + 1].x, S[2 * s2 + 1].y); wv.w = pk2(S[2 * s2 + 1].z, S[2 * s2 + 1].w);
                *(v4u*)(so + 512 * s2) = wv; }
        }
#undef GF_LOAD
    } else if (wu < GLA_H * 32 * 4 + GLA_H * (GLA_G - 1)) {
        const int u = wu - GLA_H * 32 * 4, h = u / (GLA_G - 1), g = 1 + u % (GLA_G - 1);
        const int c0 = 32 * (lane >> 3) + 16 * (lane & 1) + 4 * ((lane >> 1) & 3);
        f32x4 dl[GLA_GC];
#pragma unroll
        for (int i = 0; i < GLA_GC; ++i) dl[i] = *(const f32x4*)(B.DL + (size_t)(h * GLA_NCH + g * GLA_GC + i) * 256 + c0);
        f32x4 d = (f32x4){1.f, 1.f, 1.f, 1.f};
#pragma unroll
        for (int i = 0; i < GLA_GC; ++i) { *(f32x4*)(B.DPOS + (size_t)(h * GLA_NCH + g * GLA_GC + i) * 256 + 4 * lane) = d; d = d * dl[i]; }
    }
}
__device__ __forceinline__ void gla_out(Frame& F, const bf16* QKV, const float* norm_g, const GlaBufs& B, bf16* OG) {
    LAS bf16* As = (LAS bf16*)(F.lds);
    LAS float* part = (LAS float*)(F.lds + 16384);
    LAS unsigned char* QIs = F.lds + 20480;
    LAS float* DPs = (LAS float*)(F.lds + 20480 + 64 * 528);
    LAS unsigned char* QTs = F.lds + 55296, *KTs = F.lds + 55296 + 64 * 528;
    const int wid = F.wave;
    for (int unit = F.vcu; unit < GLA_NCH * GLA_H; unit += F.G) {
        const int n = unit >> 2, h = unit & 3, t0 = n * GLA_C;
        __syncthreads();
        int tdl = F.tid; asm volatile("" : "+v"(tdl));
        const int lane = tdl & 63, fr = lane & 15, fq = lane >> 4;
        const bool corr = n >= GLA_GC;
        v4u qst[4], qtt[4], ktt[4];
#pragma unroll
        for (int i = 0; i < 4; ++i) { const int id = tdl + 512 * i; const size_t go = (size_t)(t0 + (id >> 5)) * 1024 + h * 256 + (id & 31) * 8;
            qtt[i] = *(const v4u*)(B.QT + go); ktt[i] = *(const v4u*)(B.KT + go); qst[i] = *(const v4u*)(B.QI + go); }
        const f32x4 dst_ = *(const f32x4*)(B.DPOS + (size_t)(h * GLA_NCH + n) * 256 + 4 * (tdl & 63));
        v2u oi_[4][4];
#pragma unroll
        for (int m = 0; m < 4; ++m)
#pragma unroll
            for (int nn = 0; nn < 4; ++nn) oi_[m][nn] = *(const v2u*)(B.OI + ((((size_t)(n * GLA_H + h) * 32 + 4 * wid + 2 * (nn >> 1) + (fq >> 1)) * 4 + m) * 64 + (2 * (fq & 1) + (nn & 1)) * 16 + fr) * 4);
        __builtin_amdgcn_sched_barrier(0);
        const __amdgpu_buffer_rsrc_t s0rs = __builtin_amdgcn_make_buffer_rsrc((void*)(B.S0T + (size_t)((corr ? n / GLA_GC - 1 : 0) * GLA_H + h) * 512 * 256), 0, 512 * 256 * 2, 0x00020000);
        const int s0vo = lane * 16;
        bf16x8 sf[4][4];
        if (corr) {
#pragma unroll
            for (int s4 = 0; s4 < 4; ++s4)
#pragma unroll
                for (int nn = 0; nn < 4; ++nn) sf[s4][nn] = __builtin_bit_cast(bf16x8, __builtin_amdgcn_raw_buffer_load_b128(s0rs, s0vo, ((wid * 4 + nn) * 8 + s4) * 1024, 0));
        }
        bf16x8 vf[2][4]; v4u rr_[4][2]; f32x4 g4_[2][2];
#pragma unroll
        for (int s = 0; s < 2; ++s)
#pragma unroll
            for (int nn = 0; nn < 4; ++nn) vf[s][nn] = *(const bf16x8*)(B.VT + ((size_t)(h * GLA_NCH + n) * 512 + 64 * wid + 32 * (nn >> 1) + 8 * (fr >> 2) + 4 * (nn & 1) + (fr & 3)) * 64 + 32 * s + 8 * fq);
        __builtin_amdgcn_sched_barrier(0);
#pragma unroll
        for (int i = 0; i < 4; ++i) { const int id = tdl + 512 * i; const int lo_ = (id >> 5) * 528 + (id & 31) * 16;
            *(LAS v4u*)(QTs + lo_) = qtt[i]; *(LAS v4u*)(KTs + lo_) = ktt[i]; *(LAS v4u*)(QIs + lo_) = qst[i]; }
        if (tdl < 64) *(LAS f32x4*)(DPs + tdl * 4) = dst_;
        __syncthreads();
        {
            const int mt = wid >> 1;
            f32x4 a2[2] = {(f32x4){0.f, 0.f, 0.f, 0.f}, (f32x4){0.f, 0.f, 0.f, 0.f}};
#pragma unroll
            for (int s = 0; s < 8; ++s) { const bf16x8 qf = *(const LAS bf16x8*)(QTs + (16 * mt + fr) * 528 + s * 64 + fq * 16);
#pragma unroll
                for (int j = 0; j < 2; ++j) { const int nt = 2 * (wid & 1) + j; const bf16x8 kf = *(const LAS bf16x8*)(KTs + (16 * nt + fr) * 528 + s * 64 + fq * 16);
                    a2[j] = __builtin_amdgcn_mfma_f32_16x16x32_bf16(qf, kf, a2[j], 0, 0, 0); } }
#pragma unroll
            for (int j = 0; j < 2; ++j) { const int nt = 2 * (wid & 1) + j, col = 16 * nt + fr;
#pragma unroll
                for (int r = 0; r < 4; ++r) { const int row = 16 * mt + 4 * fq + r; As[row * 72 + col] = (bf16)f2bf(col <= row ? a2[j][r] : 0.f); } }
        }
        __syncthreads();
        f32x4 acc[4][4];
#pragma unroll
        for (int m = 0; m < 4; ++m)
#pragma unroll
            for (int nn = 0; nn < 4; ++nn) { const v2u a_ = oi_[m][nn];
                acc[m][nn] = (f32x4){bflo(a_.x), bfhi(a_.x), bflo(a_.y), bfhi(a_.y)}; }
#define GO_CORR(s0_) do { _Pragma("unroll") for (int s4 = 0; s4 < 4; ++s4) { const int sb_ = (s0_) + s4; \
            const f32x4 d0_ = *(const LAS f32x4*)(DPs + 32 * sb_ + 8 * fq), d1_ = *(const LAS f32x4*)(DPs + 32 * sb_ + 8 * fq + 4); \
            _Pragma("unroll") for (int m = 0; m < 4; ++m) { const v4u q_ = *(const LAS v4u*)(QIs + (16 * m + fr) * 528 + sb_ * 64 + fq * 16); v4u w_; \
                w_.x = pk2(bflo(q_.x) * d0_.x, bfhi(q_.x) * d0_.y); w_.y = pk2(bflo(q_.y) * d0_.z, bfhi(q_.y) * d0_.w); w_.z = pk2(bflo(q_.z) * d1_.x, bfhi(q_.z) * d1_.y); w_.w = pk2(bflo(q_.w) * d1_.z, bfhi(q_.w) * d1_.w); \
                const bf16x8 qs_ = __builtin_bit_cast(bf16x8, w_); \
                _Pragma("unroll") for (int nn = 0; nn < 4; ++nn) acc[m][nn] = __builtin_amdgcn_mfma_f32_16x16x32_bf16(sf[s4][nn], qs_, acc[m][nn], 0, 0, 0); } \
            __builtin_amdgcn_sched_barrier(0); } } while (0)
        if (corr) {
            GO_CORR(0);
#pragma unroll
            for (int s4 = 0; s4 < 4; ++s4)
#pragma unroll
                for (int nn = 0; nn < 4; ++nn) sf[s4][nn] = __builtin_bit_cast(bf16x8, __builtin_amdgcn_raw_buffer_load_b128(s0rs, s0vo, ((wid * 4 + nn) * 8 + 4 + s4) * 1024, 0));
            __builtin_amdgcn_sched_barrier(0);
        }
#pragma unroll
        for (int s = 0; s < 2; ++s) {
            bf16x8 af[4];
#pragma unroll
            for (int m = 0; m < 4; ++m) af[m] = *(const LAS bf16x8*)(As + (16 * m + fr) * 72 + 32 * s + 8 * fq);
#pragma unroll
            for (int m = 0; m < 4; ++m)
#pragma unroll
                for (int nn = 0; nn < 4; ++nn) acc[m][nn] = __builtin_amdgcn_mfma_f32_16x16x32_bf16(vf[s][nn], af[m], acc[m][nn], 0, 0, 0);
        }
        __builtin_amdgcn_sched_barrier(0);
#pragma unroll
        for (int np = 0; np < 2; ++np) { const int dv = 64 * wid + 32 * np + 8 * fq; g4_[np][0] = *(const f32x4*)(norm_g + dv); g4_[np][1] = *(const f32x4*)(norm_g + dv + 4);
#pragma unroll
            for (int m = 0; m < 4; ++m) rr_[m][np] = *(const v4u*)(QKV + (size_t)(t0 + 16 * m + fr) * NQKV + 4096 + h * 512 + dv); }
        __builtin_amdgcn_sched_barrier(0);
        if (corr) GO_CORR(4);
#undef GO_CORR
#pragma unroll
        for (int m = 0; m < 4; ++m) { float ss = 0.f;
#pragma unroll
            for (int nn = 0; nn < 4; ++nn) ss += (acc[m][nn].x * acc[m][nn].x + acc[m][nn].y * acc[m][nn].y) + (acc[m][nn].z * acc[m][nn].z + acc[m][nn].w * acc[m][nn].w);
            ss += __shfl_xor(ss, 16); ss += __shfl_xor(ss, 32);
            if (fq == 0) part[wid * 64 + 16 * m + fr] = ss; }
        __syncthreads();
#pragma unroll
        for (int m = 0; m < 4; ++m) { float tot = 0.f;
#pragma unroll
            for (int w8 = 0; w8 < 8; ++w8) tot += part[w8 * 64 + 16 * m + fr];
            const float rs = 1.f / sqrtf(tot * (1.f / 512.f) + RMS_EPS);
            const size_t ro = (size_t)(t0 + 16 * m + fr);
#pragma unroll
            for (int np = 0; np < 2; ++np) { const int dv = 64 * wid + 32 * np + 8 * fq;
                const v4u rr = rr_[m][np];
                const f32x4 o0 = acc[m][2 * np] * rs * g4_[np][0], o1 = acc[m][2 * np + 1] * rs * g4_[np][1]; v4u ov;
                ov.x = pk2(o0.x * silu(bflo(rr.x)), o0.y * silu(bfhi(rr.x))); ov.y = pk2(o0.z * silu(bflo(rr.y)), o0.w * silu(bfhi(rr.y)));
                ov.z = pk2(o1.x * silu(bflo(rr.z)), o1.y * silu(bfhi(rr.z))); ov.w = pk2(o1.z * silu(bflo(rr.w)), o1.w * silu(bfhi(rr.w)));
                *(v4u*)(OG + ro * DM + h * 512 + dv) = ov; } }
    }
}

constexpr int NPHASE = 18;
struct Args { const float* in[20]; float* out; unsigned char* ws; int ph_lo, ph_hi; };
__global__ void __launch_bounds__(NTHR, 2) mk_fwd(Args args) {
    extern __shared__ __attribute__((aligned(16))) unsigned char lds[];
    Frame F;
    F.lds = (LAS unsigned char*)lds;
    F.tid = threadIdx.x; F.lane = F.tid & 63; F.wave = __builtin_amdgcn_readfirstlane(F.tid >> 6);
    F.G = gridDim.x; { const int bx = blockIdx.x; F.vcu = (F.G % 8 == 0) ? (bx % 8) * (F.G / 8) + bx / 8 : bx; }
    unsigned char* ws = args.ws;
    F.ctl = (unsigned*)(ws + WS_CTL);
    volatile LAS unsigned* MISC = (volatile LAS unsigned*)(F.lds + MISC_OFF);
    if (F.tid < 16) MISC[F.tid] = 0u;
    __syncthreads();
    const int lo = args.ph_lo, hi = args.ph_hi;
    XcdBarrier bar; bar.bar = F.ctl + CW_BAR; bar.x = 0; bar.st = MISC;
    if (hi - lo > 1) bar = xcd_barrier_post(F.ctl + CW_BAR, MISC);
#define IN(k) (lo <= (k) && (k) < hi)
#define RUN(k) if (IN(k)) for (int rep_ = 0; rep_ < 1 + (int)((DBL_MASK >> (k)) & 1u); ++rep_, __syncthreads())
#define SEAM(k) do { if (IN(k) && IN((k) + 1)) xcd_barrier(bar); } while (0)
    const float* x = args.in[0];
    bf16* XB = (bf16*)(ws + WS_XB); bf16* QKV = (bf16*)(ws + WS_QKV); float* FLOG = (float*)(ws + WS_FLOG); float* CB = (float*)(ws + WS_CB);
    bf16* O = (bf16*)(ws + WS_O); bf16* Y = (bf16*)(ws + WS_Y);
    int* TOPE = (int*)(ws + WS_TOPE); float* TOPG = (float*)(ws + WS_TOPG); int* LIST = (int*)(ws + WS_LIST); bf16* YE = (bf16*)(ws + WS_YE); bf16* HID = (bf16*)(ws + WS_HID);
    float* WR = (float*)(ws + WS_WR); float* WGL = (float*)(ws + WS_WGL);
    const size_t MOEW = (size_t)NEXP * DM * EFF;
    const GlaBufs GB{(bf16*)(ws + WS_GQT), (bf16*)(ws + WS_GKT), (bf16*)(ws + WS_GQI), (bf16*)(ws + WS_GKET), (bf16*)(ws + WS_GVT), (float*)(ws + WS_GDL), (bf16*)(ws + WS_GOI),
                     (float*)(ws + WS_GOI2 + 24 * MiB), (float*)(ws + WS_GPE), (bf16*)(ws + WS_GOI2), (bf16*)(ws + WS_GOI2), (float*)(ws + WS_GOI2 + 16 * MiB)};

    RUN(0) {
        P0Args a{x, args.in[1], args.in[3], args.in[4], args.in[8], args.in[13], args.in[15],
                 (bf16*)(ws + WT_FOX_IN), (bf16*)(ws + WT_FOX_O), (bf16*)(ws + WT_GLA_IN), (bf16*)(ws + WT_GLA_O), WR, WGL, XB, FLOG, (void*)(ws + WS_WF)};
        p0_prologue(F, a);
    }
    SEAM(0);
    RUN(1) {
        if ((int)blockIdx.x < FOX_H) fox_cumsum(F, FLOG, args.in[2], CB, (int)blockIdx.x);
        pg8::Gemm g{XB, (const bf16*)(ws + WT_FOX_IN), T, NQKV, DM}; pg8::StaticOrder S; S.init(T, NQKV, F.G, (int)blockIdx.x);
        pg8::EpiQKVH E{QKV, T};
        pg8::gemm_phase<pg8::EpiQKVH, pg8::StaticOrder, true, true>(F.lds + RING_OFF, g, S, E);
    }
    SEAM(1);
    RUN(2) { fox::phase((char*)lds + RING_OFF, QKV, CB, O, F.vcu, F.G); }
    SEAM(2);
    RUN(3) {
        pg8::Gemm g{O, (const bf16*)(ws + WT_FOX_O), T, DM, DM}; pg8::StaticOrder S; S.init(T, DM, F.G, (int)blockIdx.x);
        pg8::EpiBf16<0> E{Y, DM, nullptr, 0, 0, 1.f};
        pg8::gemm_phase<pg8::EpiBf16<0>, pg8::StaticOrder, true, true>(F.lds + RING_OFF, g, S, E);
    }
    SEAM(3);
    RUN(4) {
        LnArgs A{Y, XB, nullptr, 2, args.in[9], args.in[10], nullptr, XB, (const float*)(ws + WS_WF), args.in[14], args.in[16], TOPE, TOPG, rep_ == 0 ? F.ctl + CW_CNT : nullptr, LIST, nullptr};
        ln_phase<9, 2>(F, A);
    }
    SEAM(4);
#ifndef MOE_VAR
#define MOE_VAR 0
#endif
    RUN(5) { MoeArgs A{F.ctl + CW_CNT, LIST, TOPG, XB, args.in[17], args.in[18], args.in[19], HID, YE, rep_ == 0 ? F.ctl + CW_MOEF : nullptr}; moe_phase<0>(F, A); }
    if (MOE_VAR != 0 && IN(5)) { __syncthreads(); MoeArgs A{F.ctl + CW_CNT, LIST, TOPG, XB, args.in[17], args.in[18], args.in[19], (bf16*)(ws + WS_END), (bf16*)(ws + WS_END)}; moe_phase<0, MOE_VAR>(F, A); }
    RUN(6) { MoeArgs A{F.ctl + CW_CNT, LIST, TOPG, XB, args.in[17], args.in[18], args.in[19], HID, YE, F.ctl + CW_MOEF}; moe_phase<1>(F, A); }
    SEAM(6);
    RUN(7) {
        LnArgs A{nullptr, XB, YE, 1, args.in[11], args.in[12], nullptr, XB, (const float*)(ws + WS_WF + (size_t)2 * 2 * 128 * 3 * 512 * 2), nullptr, nullptr, nullptr, nullptr, nullptr, nullptr, FLOG};
        ln_phase<2, 1>(F, A);
    }
    SEAM(7);
    RUN(8) {
        pg8::Gemm g{XB, (const bf16*)(ws + WT_GLA_IN), T, NQKV, DM}; pg8::StaticOrder S; S.init(T, NQKV, F.G, (int)blockIdx.x);
        pg8::EpiBf16<0> E{QKV, NQKV, nullptr, 0, 0, 1.f};
        pg8::gemm_phase<pg8::EpiBf16<0>, pg8::StaticOrder, true, true>(F.lds + RING_OFF, g, S, E);
    }
    SEAM(8);
    RUN(9) gla_prep(F, QKV, FLOG, args.in[5], args.in[6], GB);
    SEAM(9);
    RUN(10) gla_scan8(F, GB);
    SEAM(10);
    RUN(11) gla_fold(F, GB);
    SEAM(11);
    RUN(12) gla_out(F, QKV, args.in[7], GB, O);
    SEAM(12);
    RUN(13) {
        pg8::Gemm g{O, (const bf16*)(ws + WT_GLA_O), T, DM, DM}; pg8::StaticOrder S; S.init(T, DM, F.G, (int)blockIdx.x);
        pg8::EpiBf16<0> E{Y, DM, nullptr, 0, 0, 1.f};
        pg8::gemm_phase<pg8::EpiBf16<0>, pg8::StaticOrder, true, true>(F.lds + RING_OFF, g, S, E);
    }
    SEAM(13);
    RUN(14) {
        LnArgs A{Y, XB, nullptr, 2, args.in[9] + DM, args.in[10] + DM, nullptr, XB, (const float*)(ws + WS_WF + (size_t)2 * 128 * 3 * 512 * 2), args.in[14] + 8, args.in[16] + 64, TOPE, TOPG, F.ctl + CW_CNT + 64, LIST, nullptr};
        ln_phase<9, 2>(F, A);
    }
    SEAM(14);
    RUN(15) { MoeArgs A{F.ctl + CW_CNT + 64, LIST, TOPG, XB, args.in[17] + MOEW, args.in[18] + MOEW, args.in[19] + MOEW, HID, YE, rep_ == 0 ? F.ctl + CW_MOEF + 64 * 64 : nullptr}; moe_phase<0>(F, A); }
    RUN(16) { MoeArgs A{F.ctl + CW_CNT + 64, LIST, TOPG, XB, args.in[17] + MOEW, args.in[18] + MOEW, args.in[19] + MOEW, HID, YE, F.ctl + CW_MOEF + 64 * 64}; moe_phase<1>(F, A); }
    SEAM(16);
    RUN(17) {
        LnArgs A{nullptr, XB, YE, 1, args.in[11] + DM, args.in[12] + DM, args.out, nullptr, nullptr, nullptr, nullptr, nullptr, nullptr, nullptr, nullptr, nullptr};
        ln_phase<0, 1>(F, A);
    }
#ifdef PROBE_MAXCNT
    if (blockIdx.x == 0 && F.tid == 0) { unsigned mx = 0, mn = 1u << 30; for (int i = 0; i < 128; ++i) { const unsigned c = F.ctl[CW_CNT + i]; mx = c > mx ? c : mx; mn = c < mn ? c : mn; }
        if (mx > PROBE_MAXCNT || mn < PROBE_MINCNT) args.out[0] = __builtin_nanf(""); }
#endif
#ifdef EXTRA_BARS
    if (hi - lo > 1) for (int i = 0; i < EXTRA_BARS; ++i) xcd_barrier(bar);
#endif
#undef IN
#undef RUN
#undef SEAM
}

extern "C" void kernel_launch(void* const* d_in, const int* in_sizes, int n_in, void* d_out, int out_size, void* d_ws, size_t ws_size, hipStream_t stream) {
    if (n_in != 20 || in_sizes[0] != T * DM || out_size != T * DM || ws_size < WS_END) { fprintf(stderr, "kernel_launch: unexpected shapes n_in %d in0 %d out %d ws %zu\n", n_in, n_in > 0 ? in_sizes[0] : -1, out_size, ws_size); return; }
    unsigned char* ws = (unsigned char*)d_ws;
    static int grid = 0;
    if (grid == 0) {
        int dev = 0, cus = 0, per_cu = 0;
        if (hipGetDevice(&dev) != hipSuccess || hipDeviceGetAttribute(&cus, hipDeviceAttributeMultiprocessorCount, dev) != hipSuccess) { fprintf(stderr, "kernel_launch: device query failed\n"); grid = -1; return; }
        if (hipFuncSetAttribute((const void*)mk_fwd, hipFuncAttributeMaxDynamicSharedMemorySize, LDS_BYTES) != hipSuccess) { fprintf(stderr, "kernel_launch: hipFuncSetAttribute failed\n"); grid = -1; return; }
        if (hipOccupancyMaxActiveBlocksPerMultiprocessor(&per_cu, (const void*)mk_fwd, NTHR, LDS_BYTES) != hipSuccess || per_cu < 1) fprintf(stderr, "kernel_launch: occupancy query says %d per CU\n", per_cu);
        (void)hipGetLastError();
        grid = cus;
    }
    if (grid < 0) return;
    (void)hipMemsetAsync(ws + WS_CTL, 0, CTL_ZERO_BYTES, stream);
    Args a{};
    for (int i = 0; i < 20; ++i) a.in[i] = (const float*)d_in[i];
    a.out = (float*)d_out; a.ws = ws; a.ph_lo = 0; a.ph_hi = NPHASE;
    hipLaunchKernelGGL(mk_fwd, dim3(grid), dim3(NTHR), LDS_BYTES, stream, a);
}
```

```cpp
#ifndef DBL_MASK
#define DBL_MASK 0x0
#endif
#include <hip/hip_runtime.h>
#include <cstdio>
#include <cstdint>

constexpr int T = 8192, DM = 2048, NQKV = 6144, NPROJ = 6160;
constexpr int FOX_H = 16, FOX_DH = 128;
constexpr int GLA_H = 4, GLA_DK = 256, GLA_DV = 512, GLA_C = 64, GLA_NCH = T / GLA_C;
constexpr int NEXP = 64, EFF = 512;
constexpr float ALPHA = 1.4142135623730951f;
constexpr float LN_EPS = 1e-5f, RMS_EPS = 1e-6f;
constexpr float FOX_SCALE = 0.08838834764831845f;

typedef unsigned short bf16;

constexpr size_t MiB = 1u << 20;
constexpr size_t WS_CTL = 0, CTL_ZERO_BYTES = 1 * MiB;
constexpr size_t WS_XB = 2 * MiB;
constexpr size_t WS_QKV = 34 * MiB;
constexpr size_t WS_FLOG = 130 * MiB;
constexpr size_t WS_CB = 131 * MiB;
constexpr size_t WS_O = 132 * MiB;
constexpr size_t WS_Y = 164 * MiB;
constexpr size_t WS_XF = 228 * MiB;
constexpr size_t WS_XF2 = 292 * MiB;
constexpr size_t WS_TOPE = 356 * MiB;
constexpr size_t WS_TOPG = 357 * MiB;
constexpr size_t WS_LIST = 358 * MiB;
constexpr size_t WS_HID = 360 * MiB;
constexpr size_t WS_YE = 378 * MiB;
constexpr size_t WS_WT = 442 * MiB;
constexpr size_t WS_WR = 506 * MiB;
constexpr size_t WS_GLA = 508 * MiB;
constexpr size_t WS_LA = WS_GLA;
constexpr size_t WS_OR = WS_GLA + 32 * MiB;
constexpr size_t WS_GQT = WS_GLA + 96 * MiB, WS_GKT = WS_GLA + 112 * MiB, WS_GQI = WS_GLA + 128 * MiB;
constexpr size_t WS_GKET = WS_GLA + 144 * MiB;
constexpr size_t WS_GVT = WS_GLA + 160 * MiB;
constexpr size_t WS_GDL = WS_GLA + 192 * MiB;
constexpr size_t WS_GOI = WS_GLA + 193 * MiB;
constexpr size_t WS_GSE = WS_GLA + 258 * MiB;
constexpr size_t WS_GPE = WS_GLA + 274 * MiB;
constexpr size_t WS_GOI2 = WS_GLA + 275 * MiB;
constexpr size_t WS_GATE = WS_GLA + 342 * MiB;
constexpr size_t WS_END = WS_GATE + 32 * MiB;
constexpr int CW_CNT = 1024;
constexpr int CW_MOEF = 65536;

__device__ __forceinline__ unsigned f2bf(float f) { unsigned u = __builtin_bit_cast(unsigned, f); return (u + 0x7fffu + ((u >> 16) & 1u)) >> 16; }
__device__ __forceinline__ float bf2f(bf16 b) { return __builtin_bit_cast(float, (unsigned)b << 16); }
__device__ __forceinline__ float bfr(float f) { return bf2f((bf16)f2bf(f)); }
__device__ __forceinline__ float log_sigmoid(float z) { return fminf(z, 0.f) - __logf(1.f + __expf(-fabsf(z))); }
__device__ __forceinline__ float silu(float z) { return z * __builtin_amdgcn_rcpf(1.f + __expf(-z)); }

namespace pg8 {
#define PG8_LAS __attribute__((address_space(3)))
typedef unsigned short bf16_t;
typedef short bf16x8 __attribute__((ext_vector_type(8)));
typedef float f32x4 __attribute__((ext_vector_type(4)));
typedef unsigned u32x4 __attribute__((ext_vector_type(4)));
constexpr int BM = 256, BK = 64, HALF = 128, HTB = HALF * BK * 2  , STAGE_BYTES = 8 * HTB, NXCD = 8, WGM = 8;

__host__ __device__ __forceinline__ int lds_byte(int r, int c) { const int st = (r >> 4) * 2 + (c >> 5), rr = r & 15, cc = c & 31, ob = rr * 64 + cc * 2; return st * 1024 + (ob ^ (((ob >> 9) & 1) << 5)); }
__host__ __device__ __forceinline__ void stage_rc(int b, int& R, int& C) { const int st = b / 1024, sb = b % 1024, swz = sb ^ (((sb >> 9) & 1) << 5); R = (st >> 1) * 16 + swz / 64; C = (st & 1) * 32 + (swz % 64) / 2; }
__host__ __device__ __forceinline__ int perm32(int rho) { const int n = rho >> 4, i = rho & 15; return 8 * (i >> 2) + 4 * n + (i & 3); }

struct Unit { int pm, pn; };
struct Gemm { const bf16_t* A; const bf16_t* Bt; int M, N, K; };

struct StaticOrder {
    int nM, nN, nwg, G, c;
    __host__ __device__ void init(int M, int N, int G_, int c_) { nM = M / BM; nN = N / BM; nwg = nM * nN; G = G_; c = c_; }
    __host__ __device__ bool next(int i, Unit& u) const {
        const long L = (long)i * G + c; if (L >= nwg) return false;
        int wgid = (int)L; { const int q = nwg / NXCD, r = nwg % NXCD, xcd = wgid % NXCD, off = wgid / NXCD; wgid = (xcd < r ? xcd * (q + 1) : r * (q + 1) + (xcd - r) * q) + off; }
        const int nig = WGM * nN, gid = wgid / nig, fm = gid * WGM, gsz = (nM - fm) < WGM ? (nM - fm) : WGM;
        u.pm = fm + ((wgid % nig) % gsz); u.pn = (wgid % nig) / gsz; return true;
    }
    __device__ __forceinline__ void a_ready(const Unit&) const {}
    __device__ __forceinline__ void done(const Unit&) const {}
};

__device__ __forceinline__ unsigned cvt_pk_bf16(float lo, float hi) { unsigned r; asm volatile("v_cvt_pk_bf16_f32 %0, %1, %2" : "=v"(r) : "v"(lo), "v"(hi)); return r; }
typedef float f32x2 __attribute__((ext_vector_type(2)));
__device__ __forceinline__ f32x2 gelu_pk(f32x2 v) {
    const f32x2 av = __builtin_elementwise_abs(v), d = av * 0.2316418882f + 1.0f;
    f32x2 t; t.x = __builtin_amdgcn_rcpf(d.x); t.y = __builtin_amdgcn_rcpf(d.y);
    f32x2 q = t * 0.5307027145f + (-0.7265760135f); q = q * t + 0.7107068705f; q = q * t + (-0.142248368f); q = q * t + 0.127414796f; q = q * t;
    const f32x2 s = (v * v) * (-0.72134752044f);
    f32x2 e; e.x = __builtin_amdgcn_exp2f(s.x); e.y = __builtin_amdgcn_exp2f(s.y);
    const f32x2 m = v * (q * e), r = v - m;
    f32x2 o; o.x = v.x < 0.f ? m.x : r.x; o.y = v.y < 0.f ? m.y : r.y; return o;
}

template <int ACT  > struct EpiBf16 {
    static constexpr bool PERM = true, AFTER_DRAIN = false; static_assert(ACT == 0 || ACT == 1, "EpiBf16: ACT is 0 (none) or 1 (gelu_pk)");
    bf16_t* O; int ldc; const float* bias; int split_cols; size_t split_stride; float scale0;
    __device__ __forceinline__ void operator()(const f32x4 (&acc)[2][2][4][2], const Unit& u, int wr, int wc, int fr, int fq) const {
        const int row0 = u.pm * BM + wr * 64 + fr; int colt = u.pn * BM; bf16_t* base = O;
        float sc = 1.f; if (split_cols) { const int t = colt / split_cols; base += (size_t)t * split_stride; colt -= t * split_cols; if (t == 0) sc = scale0; }
        const int col0 = colt + wc * 32 + 8 * fq, bcol0 = u.pn * BM + wc * 32 + 8 * fq;
        f32x4 bv[2][2];
#pragma unroll
        for (int bj = 0; bj < 2; ++bj)
#pragma unroll
            for (int n = 0; n < 2; ++n) bv[bj][n] = bias ? *(const f32x4*)(bias + bcol0 + bj * HALF + 4 * n) : (f32x4){0.f, 0.f, 0.f, 0.f};
#pragma unroll
        for (int ai = 0; ai < 2; ++ai)
#pragma unroll
            for (int m = 0; m < 4; ++m) { bf16_t* rowp = base + (size_t)(row0 + ai * HALF + m * 16) * ldc + col0;
#pragma unroll
                for (int bj = 0; bj < 2; ++bj) { f32x4 v0 = acc[ai][bj][m][0] + bv[bj][0], v1 = acc[ai][bj][m][1] + bv[bj][1];
                    if (ACT == 1) { f32x2 a = gelu_pk((f32x2){v0[0], v0[1]}), b = gelu_pk((f32x2){v0[2], v0[3]}), c = gelu_pk((f32x2){v1[0], v1[1]}), d = gelu_pk((f32x2){v1[2], v1[3]});
                        v0 = (f32x4){a.x, a.y, b.x, b.y}; v1 = (f32x4){c.x, c.y, d.x, d.y}; }
                    v0 = v0 * sc; v1 = v1 * sc; u32x4 w; w.x = cvt_pk_bf16(v0[0], v0[1]); w.y = cvt_pk_bf16(v0[2], v0[3]); w.z = cvt_pk_bf16(v1[0], v1[1]); w.w = cvt_pk_bf16(v1[2], v1[3]);
                    *(u32x4*)(rowp + bj * HALF) = w; } }
    }
};

struct EpiQKVH { static constexpr bool PERM = true, AFTER_DRAIN = false; bf16_t* O; int rows;
    __device__ __forceinline__ void operator()(const f32x4 (&acc)[2][2][4][2], const Unit& u, int wr, int wc, int fr, int fq) const {
        const int row0 = u.pm * BM + wr * 64 + fr, which = u.pn >> 3, head0 = 2 * (u.pn & 7), d = wc * 32 + 8 * fq;
#pragma unroll
        for (int ai = 0; ai < 2; ++ai)
#pragma unroll
            for (int m = 0; m < 4; ++m) { const int row = row0 + ai * HALF + m * 16;
#pragma unroll
                for (int bj = 0; bj < 2; ++bj) { const f32x4 v0 = acc[ai][bj][m][0], v1 = acc[ai][bj][m][1];
                    u32x4 w; w.x = cvt_pk_bf16(v0[0], v0[1]); w.y = cvt_pk_bf16(v0[2], v0[3]); w.z = cvt_pk_bf16(v1[0], v1[1]); w.w = cvt_pk_bf16(v1[2], v1[3]);
                    *(u32x4*)(O + ((size_t)((which * 16 + head0 + bj) * rows + row)) * 128 + d) = w; } }
    }
};
struct EpiGla { static constexpr bool PERM = true, AFTER_DRAIN = false; bf16_t* O; int ldc; bf16_t* G;
    __device__ __forceinline__ void operator()(const f32x4 (&acc)[2][2][4][2], const Unit& u, int wr, int wc, int fr, int fq) const {
        const int colt = u.pn * BM;
        if (colt < 4096) {
            const int row0 = u.pm * BM + wr * 64 + fr, col0 = colt + wc * 32 + 8 * fq;
#pragma unroll
            for (int ai = 0; ai < 2; ++ai)
#pragma unroll
                for (int m = 0; m < 4; ++m) { bf16_t* rowp = O + (size_t)(row0 + ai * HALF + m * 16) * ldc + col0;
#pragma unroll
                    for (int bj = 0; bj < 2; ++bj) { const f32x4 v0 = acc[ai][bj][m][0], v1 = acc[ai][bj][m][1];
                        u32x4 w; w.x = cvt_pk_bf16(v0[0], v0[1]); w.y = cvt_pk_bf16(v0[2], v0[3]); w.z = cvt_pk_bf16(v1[0], v1[1]); w.w = cvt_pk_bf16(v1[2], v1[3]);
                        *(u32x4*)(rowp + bj * HALF) = w; } }
        } else {
            const int hh = (u.pn - 16) >> 1, wq = 4 * (u.pn & 1) + (wc >> 1), np = wc & 1;
#pragma unroll
            for (int ai = 0; ai < 2; ++ai) { const int nch = u.pm * 4 + ai * 2 + wr;
#pragma unroll
                for (int m = 0; m < 4; ++m)
#pragma unroll
                    for (int bj = 0; bj < 2; ++bj) { const f32x4 v0 = acc[ai][bj][m][0], v1 = acc[ai][bj][m][1];
                        u32x4 w; w.x = cvt_pk_bf16(v0[0], v0[1]); w.y = cvt_pk_bf16(v0[2], v0[3]); w.z = cvt_pk_bf16(v1[0], v1[1]); w.w = cvt_pk_bf16(v1[2], v1[3]);
                        *(u32x4*)(G + ((((((size_t)(nch * 4 + hh) * 8 + wq + 2 * bj) * 4 + m) * 2 + np) * 64 + fq * 16 + fr) * 8)) = w; } }
        }
    }
};
template <bool RBF16>
struct EpiRes { static constexpr bool PERM = false, AFTER_DRAIN = false; bf16_t* C; const void* R; int ldc; float alpha;
    __device__ __forceinline__ void operator()(const f32x4 (&acc)[2][2][4][2], const Unit& u, int wr, int wc, int fr, int fq) const {
        const int row0 = u.pm * BM + wr * 64 + fr, col0 = u.pn * BM + wc * 32 + 4 * fq;
        typedef unsigned v2u_ __attribute__((ext_vector_type(2)));
#pragma unroll
        for (int ai = 0; ai < 2; ++ai) {
            f32x4 rf[RBF16 ? 1 : 4][2][2]; v2u_ rb[RBF16 ? 4 : 1][2][2];
#pragma unroll
            for (int m = 0; m < 4; ++m) { const size_t ro = (size_t)(row0 + ai * HALF + m * 16) * ldc + col0;
#pragma unroll
                for (int bj = 0; bj < 2; ++bj)
#pragma unroll
                    for (int n = 0; n < 2; ++n) {
                        if constexpr (RBF16) rb[m][bj][n] = *(const v2u_*)((const bf16_t*)R + ro + bj * HALF + n * 16);
                        else rf[m][bj][n] = *(const f32x4*)((const float*)R + ro + bj * HALF + n * 16); } }
            __builtin_amdgcn_sched_barrier(0);
#pragma unroll
            for (int m = 0; m < 4; ++m) { const size_t ro = (size_t)(row0 + ai * HALF + m * 16) * ldc + col0;
#pragma unroll
                for (int bj = 0; bj < 2; ++bj)
#pragma unroll
                    for (int n = 0; n < 2; ++n) { f32x4 r;
                        if constexpr (RBF16) { const v2u_ p = rb[m][bj][n];
                            r = (f32x4){__builtin_bit_cast(float, p.x << 16), __builtin_bit_cast(float, p.x & 0xffff0000u), __builtin_bit_cast(float, p.y << 16), __builtin_bit_cast(float, p.y & 0xffff0000u)}; }
                        else r = rf[m][bj][n];
                        const f32x4 o = r * alpha + acc[ai][bj][m][n]; v2u_ w; w.x = cvt_pk_bf16(o[0], o[1]); w.y = cvt_pk_bf16(o[2], o[3]);
                        *(v2u_*)(C + ro + bj * HALF + n * 16) = w; } }
            __builtin_amdgcn_sched_barrier(0);
        }
    }
};
template <class Epi, class Sched, bool ALIGN_EPI = false, bool SP2 = false>
__device__ __forceinline__ void gemm_phase(PG8_LAS unsigned char* lds, const Gemm g, const Sched& S, const Epi& E) {
    const int tid = threadIdx.x, wid = __builtin_amdgcn_readfirstlane(tid >> 6), lane = tid & 63, wr = wid >> 2, wc = wid & 3, fr = lane & 15, fq = lane >> 4;
    const int K = g.K, nt = K / BK;
    unsigned voffA[2], voffB[2];
#pragma unroll
    for (int i = 0; i < 2; ++i) { int R, C; stage_rc(tid * 16 + i * 8192, R, C); const int Rb = Epi::PERM ? ((R & ~31) + perm32(R & 31)) : R;
        voffA[i] = (unsigned)(R * K + C) * 2u; voffB[i] = (unsigned)(Rb * K + C) * 2u; }
    const size_t kstep = (size_t)(BK * 2);
    const size_t hstep = (size_t)HALF * K * 2;
    const size_t tstep = 2 * hstep;
    const unsigned ldsw = (unsigned)wid * 1024u;
    const int aoff = lds_byte(wr * 64 + fr, fq * 8), boff = lds_byte(wc * 32 + fr, fq * 8);
#define PG8_SA(b, h) (((b) * 2 + (h)) * HTB)
#define PG8_SB(b, h) ((4 + (b) * 2 + (h)) * HTB)
#define PG8_STAGE(bufoff, gbase, voff) do { _Pragma("unroll") for (int _i = 0; _i < 2; ++_i) \
        __builtin_amdgcn_global_load_lds((const unsigned*)((const char*)(gbase) + (voff)[_i]), (PG8_LAS unsigned*)(lds + (bufoff) + ldsw + _i * 8192), 16, 0, 0); } while (0)
#define PG8_LDA(dst, b, h) do { _Pragma("unroll") for (int m = 0; m < 4; ++m) _Pragma("unroll") for (int k = 0; k < 2; ++k) dst[m][k] = *(const PG8_LAS bf16x8*)(lds + PG8_SA(b, h) + aoff + m * 2048 + k * 1024); } while (0)
#define PG8_LDB(dst, b, h) do { _Pragma("unroll") for (int n = 0; n < 2; ++n) _Pragma("unroll") for (int k = 0; k < 2; ++k) dst[n][k] = *(const PG8_LAS bf16x8*)(lds + PG8_SB(b, h) + boff + n * 2048 + k * 1024); } while (0)
#define PG8_MMA(ai, bj, At, Bt) do { __builtin_amdgcn_s_setprio(1); _Pragma("unroll") for (int m = 0; m < 4; ++m) _Pragma("unroll") for (int n = 0; n < 2; ++n) _Pragma("unroll") for (int k = 0; k < 2; ++k) \
        acc[ai][bj][m][n] = __builtin_amdgcn_mfma_f32_16x16x32_bf16(Bt[n][k], At[m][k], acc[ai][bj][m][n], 0, 0, 0); __builtin_amdgcn_s_setprio(0); } while (0)
#define PG8_WAIT_V(n) asm volatile("s_waitcnt vmcnt(" #n ")" ::: "memory")
#define PG8_WAIT_L(n) asm volatile("s_waitcnt lgkmcnt(" #n ")" ::: "memory")
#define PG8_BAR __builtin_amdgcn_s_barrier()
#define PG8_SCHED __builtin_amdgcn_sched_barrier(0)
    Unit cur, nxt; int ui = 0;
    if (!S.next(0, cur)) return;
    f32x4 acc[2][2][4][2];
#pragma unroll
    for (int a = 0; a < 2; ++a)
#pragma unroll
        for (int b = 0; b < 2; ++b)
#pragma unroll
            for (int m = 0; m < 4; ++m)
#pragma unroll
                for (int n = 0; n < 2; ++n) acc[a][b][m][n] = (f32x4){0.f, 0.f, 0.f, 0.f};
    bf16x8 At[4][2], B0[2][2], B1[2][2];
    const char* cA = (const char*)g.A + (size_t)cur.pm * tstep; const char* cB = (const char*)g.Bt + (size_t)cur.pn * tstep;
    S.a_ready(cur);
    if constexpr (SP2) {
        PG8_STAGE(PG8_SB(0, 0), cB, voffB); PG8_STAGE(PG8_SB(0, 1), cB + hstep, voffB); PG8_STAGE(PG8_SA(0, 0), cA, voffA); PG8_STAGE(PG8_SA(0, 1), cA + hstep, voffA);
        if (wr == 1) PG8_BAR;
        PG8_WAIT_V(2); PG8_BAR;
        PG8_STAGE(PG8_SB(1, 0), cB + kstep, voffB); PG8_STAGE(PG8_SA(1, 0), cA + kstep, voffA); PG8_STAGE(PG8_SB(1, 1), cB + hstep + kstep, voffB);
        PG8_WAIT_V(6); PG8_BAR;
    } else {
        PG8_STAGE(PG8_SB(0, 0), cB, voffB); PG8_STAGE(PG8_SA(0, 0), cA, voffA); PG8_STAGE(PG8_SB(0, 1), cB + hstep, voffB); PG8_STAGE(PG8_SA(0, 1), cA + hstep, voffA);
        if (wr == 1) PG8_BAR;
        PG8_WAIT_V(4); PG8_BAR;
        PG8_STAGE(PG8_SB(1, 0), cB + kstep, voffB); PG8_STAGE(PG8_SA(1, 0), cA + kstep, voffA); PG8_STAGE(PG8_SB(1, 1), cB + hstep + kstep, voffB);
        PG8_WAIT_V(6); PG8_BAR;
    }
    for (;;) {
        const bool has_next = S.next(ui + 1, nxt);
        const char* nA = has_next ? (const char*)g.A + (size_t)nxt.pm * tstep : cA; const char* nB = has_next ? (const char*)g.Bt + (size_t)nxt.pn * tstep : cB;
        for (int t = 0; t < nt; t += 2) {
            const bool last = (t == nt - 2);
            const char* a1 = cA + (size_t)(t + 1) * kstep;
            const char* a2 = last ? nA : cA + (size_t)(t + 2) * kstep; const char* b2 = last ? nB : cB + (size_t)(t + 2) * kstep;
            const char* a3 = a2 + kstep; const char* b3 = b2 + kstep;
            if (last && has_next) S.a_ready(nxt);
            if constexpr (SP2) {
            PG8_LDB(B0, 0, 0); PG8_LDB(B1, 0, 1); PG8_SCHED; PG8_LDA(At, 0, 0); PG8_STAGE(PG8_SA(1, 1), a1 + hstep, voffA);
            PG8_WAIT_V(8); PG8_WAIT_L(0); PG8_BAR; PG8_MMA(0, 0, At, B0); PG8_MMA(0, 1, At, B1); PG8_BAR; PG8_SCHED;
            PG8_LDA(At, 0, 1); PG8_STAGE(PG8_SB(0, 0), b2, voffB); PG8_STAGE(PG8_SB(0, 1), b2 + hstep, voffB); PG8_STAGE(PG8_SA(0, 0), a2, voffA);
            PG8_WAIT_V(8); PG8_WAIT_L(0); PG8_BAR; PG8_MMA(1, 0, At, B0); PG8_MMA(1, 1, At, B1); PG8_BAR; PG8_SCHED;
            PG8_LDB(B0, 1, 0); PG8_LDB(B1, 1, 1); PG8_SCHED; PG8_LDA(At, 1, 0); PG8_STAGE(PG8_SA(0, 1), a2 + hstep, voffA);
            PG8_WAIT_V(8); PG8_WAIT_L(0); PG8_BAR; PG8_MMA(0, 0, At, B0); PG8_MMA(0, 1, At, B1); PG8_BAR; PG8_SCHED;
            PG8_LDA(At, 1, 1); PG8_STAGE(PG8_SB(1, 0), b3, voffB); PG8_STAGE(PG8_SB(1, 1), b3 + hstep, voffB); PG8_STAGE(PG8_SA(1, 0), a3, voffA);
            PG8_WAIT_V(8); PG8_WAIT_L(0); PG8_BAR; PG8_MMA(1, 0, At, B0); PG8_MMA(1, 1, At, B1); PG8_BAR; PG8_SCHED;
            } else {
            PG8_LDB(B0, 0, 0); PG8_SCHED; PG8_LDA(At, 0, 0); PG8_STAGE(PG8_SA(1, 1), a1 + hstep, voffA);
            PG8_WAIT_L(8); PG8_BAR; PG8_WAIT_L(0); PG8_MMA(0, 0, At, B0); PG8_BAR; PG8_SCHED;
            PG8_LDB(B1, 0, 1); PG8_STAGE(PG8_SB(0, 0), b2, voffB);
            PG8_BAR; PG8_WAIT_L(0); PG8_MMA(0, 1, At, B1); PG8_BAR;
            PG8_LDA(At, 0, 1); PG8_STAGE(PG8_SA(0, 0), a2, voffA);
            PG8_BAR; PG8_WAIT_L(0); PG8_MMA(1, 0, At, B0); PG8_BAR; PG8_SCHED;
            PG8_STAGE(PG8_SB(0, 1), b2 + hstep, voffB);
            PG8_WAIT_V(6); PG8_BAR; PG8_MMA(1, 1, At, B1); PG8_BAR;
            PG8_LDB(B0, 1, 0); PG8_SCHED; PG8_LDA(At, 1, 0); PG8_STAGE(PG8_SA(0, 1), a2 + hstep, voffA);
            PG8_WAIT_L(8); PG8_BAR; PG8_WAIT_L(0); PG8_MMA(0, 0, At, B0); PG8_BAR; PG8_SCHED;
            PG8_LDB(B1, 1, 1); PG8_STAGE(PG8_SB(1, 0), b3, voffB);
            PG8_BAR; PG8_WAIT_L(0); PG8_MMA(0, 1, At, B1); PG8_BAR;
            PG8_LDA(At, 1, 1); PG8_STAGE(PG8_SA(1, 0), a3, voffA);
            PG8_BAR; PG8_WAIT_L(0); PG8_MMA(1, 0, At, B0); PG8_BAR; PG8_SCHED;
            PG8_STAGE(PG8_SB(1, 1), b3 + hstep, voffB);
            PG8_WAIT_V(6); PG8_BAR; PG8_MMA(1, 1, At, B1); PG8_BAR;
            }
        }
        if constexpr (ALIGN_EPI) { if (wr == 0) PG8_BAR; }
        if constexpr (!Epi::AFTER_DRAIN) { E(acc, cur, wr, wc, fr, fq); S.done(cur); }
        if (!has_next) break;
#pragma unroll
        for (int a = 0; a < 2; ++a)
#pragma unroll
            for (int b = 0; b < 2; ++b)
#pragma unroll
                for (int m = 0; m < 4; ++m)
#pragma unroll
                    for (int n = 0; n < 2; ++n) acc[a][b][m][n] = (f32x4){0.f, 0.f, 0.f, 0.f};
        cur = nxt; cA = nA; cB = nB; ++ui;
        if constexpr (ALIGN_EPI) { if (wr == 1) PG8_BAR; }
    }
    PG8_WAIT_V(0);
    if constexpr (!ALIGN_EPI) { if (wr == 0) PG8_BAR; }
    PG8_BAR;
    if constexpr (Epi::AFTER_DRAIN) { E.fused(acc, cur, wr, wc, fr, fq, lds, wid, lane); S.done(cur); }
#undef PG8_SA
#undef PG8_SB
#undef PG8_STAGE
#undef PG8_LDA
#undef PG8_LDB
#undef PG8_MMA
#undef PG8_WAIT_V
#undef PG8_WAIT_L
#undef PG8_BAR
#undef PG8_SCHED
}
}

#define GAS __attribute__((address_space(1)))
#define LAS __attribute__((address_space(3)))
typedef unsigned v4u __attribute__((ext_vector_type(4)));
typedef unsigned v2u __attribute__((ext_vector_type(2)));
typedef float f32x4 __attribute__((ext_vector_type(4)));
typedef short bf16x8 __attribute__((ext_vector_type(8)));
#define LDS_WAIT() asm volatile("s_waitcnt lgkmcnt(0)" ::: "memory")
#define VM_WAIT() asm volatile("s_waitcnt vmcnt(0)" ::: "memory")
__device__ __forceinline__ float bflo(unsigned u) { return __builtin_bit_cast(float, u << 16); }
__device__ __forceinline__ float bfhi(unsigned u) { return __builtin_bit_cast(float, u & 0xffff0000u); }
__device__ __forceinline__ void st8_wt(void* p, unsigned lo_, unsigned hi_) { typedef unsigned u2_ __attribute__((ext_vector_type(2))); const u2_ v = {lo_, hi_}; asm volatile("global_store_dwordx2 %0, %1, off sc1\n\ts_nop 1" :: "v"(p), "v"(v) : "memory"); }
__device__ __forceinline__ void st16_wt(void* p, unsigned a_, unsigned b_, unsigned c_, unsigned d_) { typedef unsigned u4_ __attribute__((ext_vector_type(4))); const u4_ v = {a_, b_, c_, d_}; asm volatile("global_store_dwordx4 %0, %1, off sc1\n\ts_nop 1" :: "v"(p), "v"(v) : "memory"); }
typedef __bf16 bf16x2_t __attribute__((ext_vector_type(2)));
typedef float f32x2_t __attribute__((ext_vector_type(2)));
__device__ __forceinline__ unsigned pk2(float lo, float hi) { const f32x2_t v = {lo, hi}; const bf16x2_t b = __builtin_convertvector(v, bf16x2_t); return __builtin_bit_cast(unsigned, b); }

constexpr int NWAVES = 8, NTHR = 512;
constexpr int RING_OFF = 0, RING_BYTES = 131072;
constexpr int LDS_BYTES = 147456;
constexpr int MISC_OFF = LDS_BYTES - 64;
constexpr int XTRA_OFF = RING_BYTES;
constexpr size_t WT_FOX_IN = WS_WT, WT_FOX_O = WS_WT + 24 * MiB, WT_GLA_IN = WS_WT + 32 * MiB, WT_GLA_O = WS_WT + 56 * MiB;
constexpr size_t WS_WGL = WS_WR + 2 * 72 * 2048 * 4;
constexpr size_t WS_WF = WS_GLA + 340 * MiB;

#define XB_TMO      128
#define XB_XCNT(j)  (256  + 64 * (j))
#define XB_XSUB(j)  (1280 + 64 * (j))
#define XB_XGEN(j)  (2304 + 64 * (j))
#define XB_TOP      3328
#define XB_TOPGEN   3392
#define XCD_BAR_WORDS 3456
#define XB_SPIN_CAP (1u << 18)
constexpr int CW_BAR = 4096;
__device__ __forceinline__ unsigned xb_ld(unsigned* p)              { return __hip_atomic_load(p, __ATOMIC_RELAXED, __HIP_MEMORY_SCOPE_AGENT); }
__device__ __forceinline__ unsigned xb_add(unsigned* p, unsigned v) { return __hip_atomic_fetch_add(p, v, __ATOMIC_RELAXED, __HIP_MEMORY_SCOPE_AGENT); }
__device__ __forceinline__ unsigned xb_xcc_id() { return (unsigned)__builtin_amdgcn_s_getreg((3 << 11) | 20) & 0xFu; }
#define XB_SPIN(cond, bar) do { unsigned _sp = 0; while (cond) { __builtin_amdgcn_s_sleep(1); \
    if ((++_sp & 255u) == 0u) { if (xb_ld(&(bar)[XB_TMO])) break; if (_sp > XB_SPIN_CAP) { atomicAdd(&(bar)[XB_TMO], 1u); break; } } } } while (0)
struct XcdBarrier { unsigned* bar; unsigned x; volatile LAS unsigned* st; };
__device__ __forceinline__ XcdBarrier xcd_barrier_post(unsigned* bar, volatile LAS unsigned* st) {
    XcdBarrier b; b.bar = bar; b.x = xb_xcc_id(); b.st = st;
    if (threadIdx.x == 0) (void)xb_add(&bar[XB_XCNT(b.x)], 1u);
    return b;
}
__device__ __forceinline__ void xcd_barrier_complete(unsigned* bar, unsigned x, unsigned& nloc, unsigned& nx) {
    const unsigned G = gridDim.x * gridDim.y * gridDim.z;
    unsigned sum, cnt, mine, sp = 0u;
    for (;;) {
        sum = 0u; cnt = 0u; mine = 0u;
#pragma unroll
        for (unsigned j = 0; j < 16; ++j) { const unsigned c = xb_ld(&bar[XB_XCNT(j)]); sum += c; cnt += (c > 0u) ? 1u : 0u; mine = (j == x) ? c : mine; }
        if (sum == G) break;
        __builtin_amdgcn_s_sleep(1);
        if ((++sp & 255u) == 0u) { if (xb_ld(&bar[XB_TMO])) break; if (sp > XB_SPIN_CAP) { atomicAdd(&bar[XB_TMO], 1u); break; } }
    }
    nloc = mine > 0u ? mine : 1u; nx = cnt > 0u ? cnt : 1u;
}
__device__ __forceinline__ void xcd_barrier(const XcdBarrier& b) {
    asm volatile("s_waitcnt vmcnt(0)" ::: "memory");
    __syncthreads();
    if (threadIdx.x == 0) {
        unsigned* bar = b.bar;
        __builtin_amdgcn_s_waitcnt(0);
        unsigned nloc = b.st[0], nx = b.st[1];
        if (nloc == 0u) { xcd_barrier_complete(bar, b.x, nloc, nx); b.st[0] = nloc; b.st[1] = nx; }
        const unsigned old = xb_add(&bar[XB_XSUB(b.x)], 1u);
        const unsigned gen = old / nloc;
        if (old + 1u == (gen + 1u) * nloc) {
            __builtin_amdgcn_fence(__ATOMIC_RELEASE, "agent");
            asm volatile("s_waitcnt vmcnt(0)" ::: "memory");
            const unsigned og = xb_add(&bar[XB_TOP], 1u);
            const unsigned tg = og / nx;
            if (og + 1u == (tg + 1u) * nx) xb_add(&bar[XB_TOPGEN], 1u);
            else XB_SPIN(xb_ld(&bar[XB_TOPGEN]) == tg, bar);
            __builtin_amdgcn_fence(__ATOMIC_ACQUIRE, "agent");
            xb_add(&bar[XB_XGEN(b.x)], 1u);
            asm volatile("s_waitcnt vmcnt(0)" ::: "memory");
        } else {
            XB_SPIN(xb_ld(&bar[XB_XGEN(b.x)]) == gen, bar);
            __builtin_amdgcn_fence(__ATOMIC_ACQUIRE, "agent");
            asm volatile("s_waitcnt vmcnt(0)" ::: "memory");
        }
    }
    __syncthreads();
}

struct Frame {
    LAS unsigned char* lds;
    unsigned* ctl;
    int tid, lane, wave, G, vcu;
};
__device__ __forceinline__ float wave_sum(float v) {
#pragma unroll
    for (int o = 1; o < 64; o <<= 1) v += __shfl_xor(v, o);
    return v;
}
template <int N, int MASK> __device__ __forceinline__ void rs_step(float* v, int lane) {
    const bool up = (lane & MASK) != 0;
#pragma unroll
    for (int i = 0; i < N / 2; ++i) { const float send = up ? v[i] : v[i + N / 2]; const float keep = up ? v[i + N / 2] : v[i]; v[i] = keep + __shfl_xor(send, MASK); }
}
__device__ __forceinline__ void rs64(float (&v)[64], int lane) { rs_step<64, 32>(v, lane); rs_step<32, 16>(v, lane); rs_step<16, 8>(v, lane); rs_step<8, 4>(v, lane); rs_step<4, 2>(v, lane); rs_step<2, 1>(v, lane); }
__device__ __forceinline__ void rs32(float (&v)[32], int lane) { rs_step<32, 32>(v, lane); rs_step<16, 16>(v, lane); rs_step<8, 8>(v, lane); rs_step<4, 4>(v, lane); rs_step<2, 2>(v, lane); v[0] += __shfl_xor(v[0], 1); }

typedef short s16x4 __attribute__((ext_vector_type(4)));
typedef short v4i16_t __attribute__((__vector_size__(4 * sizeof(short))));
__device__ __forceinline__ s16x4 lds_tr16(const LAS unsigned char* p) { return __builtin_bit_cast(s16x4, __builtin_amdgcn_ds_read_tr16_b64_v4i16((LAS v4i16_t*)p)); }
__device__ __forceinline__ void p0_transpose_item(const float* W, int ldw, int ncols, int K, bf16* WT, LAS unsigned char* scr, int item, int lane) {
    const int nblk = ncols / 64, kb0 = item / nblk, nb = item % nblk, k0 = 64 * kb0, n0 = 64 * nb;
    f32x4 w[16];
#pragma unroll
    for (int i = 0; i < 16; ++i) w[i] = __builtin_nontemporal_load((const f32x4*)(W + (size_t)(k0 + 4 * i + (lane >> 4)) * ldw + n0 + (lane & 15) * 4));
#pragma unroll
    for (int i = 0; i < 16; ++i) { v2u o; o.x = pk2(w[i].x, w[i].y); o.y = pk2(w[i].z, w[i].w); *(LAS v2u*)(scr + (4 * i + (lane >> 4)) * 192 + (lane & 15) * 8) = o; }
    LDS_WAIT(); asm volatile("" ::: "memory");
    const int tr_rd = (8 * (lane >> 4) + ((lane >> 2) & 3)) * 192 + (4 * (lane & 3)) * 2, tr_col = lane & 15, tr_k = 8 * (lane >> 4);
#pragma unroll
    for (int st = 0; st < 8; ++st) { const int cb = (st >> 1) * 16, kb = (st & 1) * 32;
        const s16x4 l_ = lds_tr16(scr + kb * 192 + cb * 2 + tr_rd), h_ = lds_tr16(scr + (kb + 4) * 192 + cb * 2 + tr_rd);
        *(bf16x8*)(WT + (size_t)(n0 + cb + tr_col) * K + k0 + kb + tr_k) = (bf16x8){l_[0], l_[1], l_[2], l_[3], h_[0], h_[1], h_[2], h_[3]}; }
    LDS_WAIT(); asm volatile("" ::: "memory");
}
struct P0Args { const float* x; const float* fox_w_in; const float* fox_w_o; const float* gla_w_in; const float* gla_w_o; const float* w_group; const float* w_expert;
                bf16* wt_fox_in; bf16* wt_fox_o; bf16* wt_gla_in; bf16* wt_gla_o; float* WR; float* WGL; bf16* XB; float* FLOG; void* WF; };
__device__ __forceinline__ void p0_prologue(Frame& F, const P0Args& a) {
    LAS unsigned char* scr = F.lds + RING_OFF + F.wave * 16384;
    const int gw = F.vcu * NWAVES + F.wave, NGW = F.G * NWAVES;
    {
        LAS float* WfT = (LAS float*)(F.lds + RING_OFF);
#pragma unroll 4
        for (int i = 0; i < 16; ++i) { const int idx = F.tid + NTHR * i, k = idx >> 2, cg = idx & 3;
            const f32x4 w = *(const f32x4*)(a.fox_w_in + (size_t)k * NPROJ + NQKV + 4 * cg);
            WfT[(4 * cg + 0) * DM + k] = w.x; WfT[(4 * cg + 1) * DM + k] = w.y; WfT[(4 * cg + 2) * DM + k] = w.z; WfT[(4 * cg + 3) * DM + k] = w.w; }
        __syncthreads();
        for (int it = gw; it < T / 4; it += NGW) {
            const int row0 = it * 4;
            float acc[64];
#pragma unroll
            for (int i = 0; i < 64; ++i) acc[i] = 0.f;
#pragma unroll 1
            for (int j = 0; j < 8; ++j) {
                f32x4 xr[4];
#pragma unroll
                for (int r = 0; r < 4; ++r) { xr[r] = *((const f32x4*)(a.x + (size_t)(row0 + r) * DM) + 64 * j + F.lane);
                    v2u o; o.x = pk2(xr[r].x, xr[r].y); o.y = pk2(xr[r].z, xr[r].w); *((v2u*)(a.XB + (size_t)(row0 + r) * DM) + 64 * j + F.lane) = o; }
#pragma unroll
                for (int c = 0; c < 16; ++c) { const f32x4 w = *((const LAS f32x4*)(WfT + c * DM) + 64 * j + F.lane);
#pragma unroll
                    for (int r = 0; r < 4; ++r) acc[r * 16 + c] += (xr[r].x * w.x + xr[r].y * w.y) + (xr[r].z * w.z + xr[r].w * w.w); }
            }
            rs64(acc, F.lane);
            a.FLOG[(size_t)(F.lane & 15) * T + row0 + (F.lane >> 4)] = acc[0];
        }
        __syncthreads();
    }
    constexpr int I_IN = (DM / 64) * (NQKV / 64), I_O = (DM / 64) * (DM / 64);
    for (int it = gw; it < 2 * (I_IN + I_O); it += NGW) {
        int r = it;
        if (r < I_IN) { p0_transpose_item(a.fox_w_in, NPROJ, NQKV, DM, a.wt_fox_in, scr, r, F.lane); continue; } r -= I_IN;
        if (r < I_O) { p0_transpose_item(a.fox_w_o, DM, DM, DM, a.wt_fox_o, scr, r, F.lane); continue; } r -= I_O;
        if (r < I_IN) { p0_transpose_item(a.gla_w_in, NPROJ, NQKV, DM, a.wt_gla_in, scr, r, F.lane); continue; } r -= I_IN;
        p0_transpose_item(a.gla_w_o, DM, DM, DM, a.wt_gla_o, scr, r, F.lane);
    }
    {
        bf16* WF = (bf16*)a.WF;
        for (int i = F.vcu * NTHR + F.tid; i < 2 * 128 * 3 * 64; i += F.G * NTHR) {
            const int l = i / (128 * 3 * 64), rem = i % (128 * 3 * 64), s = rem / 192, nt = (rem % 192) / 64, ln = rem % 64, n = 32 * nt + (ln & 31), k0 = 16 * s + 8 * (ln >> 5);
            unsigned hi[4], lo[4];
#pragma unroll
            for (int jp = 0; jp < 4; ++jp) { float w0 = 0.f, w1 = 0.f;
                if (n < 64) { w0 = a.w_expert[((size_t)l * DM + k0 + 2 * jp) * 64 + n]; w1 = a.w_expert[((size_t)l * DM + k0 + 2 * jp + 1) * 64 + n]; }
                else if (n < 72) { w0 = a.w_group[((size_t)l * DM + k0 + 2 * jp) * 8 + (n - 64)]; w1 = a.w_group[((size_t)l * DM + k0 + 2 * jp + 1) * 8 + (n - 64)]; }
                hi[jp] = pk2(w0, w1); lo[jp] = pk2(w0 - bflo(hi[jp]), w1 - bfhi(hi[jp])); }
            v4u h4, l4; h4.x = hi[0]; h4.y = hi[1]; h4.z = hi[2]; h4.w = hi[3]; l4.x = lo[0]; l4.y = lo[1]; l4.z = lo[2]; l4.w = lo[3];
            *(v4u*)(WF + ((size_t)((l * 2 + 0) * 128 + s) * 3 + nt) * 512 + ln * 8) = h4;
            *(v4u*)(WF + ((size_t)((l * 2 + 1) * 128 + s) * 3 + nt) * 512 + ln * 8) = l4;
        }
    }
    {
        bf16* WFG = (bf16*)a.WF + (size_t)2 * 2 * 128 * 3 * 512;
        for (int i = F.vcu * NTHR + F.tid; i < 128 * 64; i += F.G * NTHR) { const int s = i >> 6, ln = i & 63, n = ln & 31, k0 = 16 * s + 8 * (ln >> 5);
            unsigned hi[4], lo[4];
#pragma unroll
            for (int jp = 0; jp < 4; ++jp) { float w0 = 0.f, w1 = 0.f;
                if (n < 16) { w0 = a.gla_w_in[(size_t)(k0 + 2 * jp) * NPROJ + NQKV + n]; w1 = a.gla_w_in[(size_t)(k0 + 2 * jp + 1) * NPROJ + NQKV + n]; }
                hi[jp] = pk2(w0, w1); lo[jp] = pk2(w0 - bflo(hi[jp]), w1 - bfhi(hi[jp])); }
            v4u h4, l4; h4.x = hi[0]; h4.y = hi[1]; h4.z = hi[2]; h4.w = hi[3]; l4.x = lo[0]; l4.y = lo[1]; l4.z = lo[2]; l4.w = lo[3];
            *(v4u*)(WFG + (size_t)s * 512 + ln * 8) = h4; *(v4u*)(WFG + (size_t)(128 + s) * 512 + ln * 8) = l4; }
    }
}
__device__ __forceinline__ void fox_cumsum(Frame& F, const float* FLOG, const float* b_f, float* CB, int h) {
    LAS float* red = (LAS float*)(F.lds + XTRA_OFF);
    const float bf = b_f[h];
    float lf[16]; float s = 0.f;
#pragma unroll
    for (int i = 0; i < 4; ++i) { const f32x4 v = *((const f32x4*)(FLOG + (size_t)h * T + F.tid * 16) + i); lf[4 * i] = v.x; lf[4 * i + 1] = v.y; lf[4 * i + 2] = v.z; lf[4 * i + 3] = v.w; }
#pragma unroll
    for (int i = 0; i < 16; ++i) { lf[i] = log_sigmoid(lf[i] + bf); s += lf[i]; }
    float inc = s;
#pragma unroll
    for (int o = 1; o < 64; o <<= 1) { const float t = __shfl_up(inc, o); if (F.lane >= o) inc += t; }
    if (F.lane == 63) red[F.wave] = inc;
    __syncthreads();
    float base = inc - s;
    for (int w = 0; w < F.wave; ++w) base += red[w];
#pragma unroll
    for (int i = 0; i < 16; ++i) { base += lf[i]; CB[(size_t)h * T + F.tid * 16 + i] = -base * (1.f / FOX_SCALE); }
    __syncthreads();
}


struct LnArgs { const bf16* Y; const bf16* X; const bf16* YE; int mode; const float* g; const float* b; float* XF; bf16* XBo;
                const float* WT; const float* bg; const float* be; int* TOPE; float* TOPG; unsigned* CNT; int* LIST; float* GLOW; };
__device__ __forceinline__ void ln_issue_chunk(Frame& F, const float* WT, int g, int buf) {
    const char* src = (const char*)(WT + (size_t)g * 8 * DM) + F.wave * 1024 + F.lane * 16;
    LAS unsigned char* dst = F.lds + RING_OFF + buf * 65536 + F.wave * 1024;
#pragma unroll 1
    for (int i = 0; i < 8; ++i) { __builtin_amdgcn_global_load_lds((const unsigned*)src, (LAS unsigned*)dst, 16, 0, 0); src += 8192; dst += 8192; }
}
template <int NG, int MODE>
__device__ __forceinline__ void ln_phase(Frame& F, const LnArgs& A) {
    for (int unit = F.vcu; unit < T / 32; unit += F.G) {
        const int row0 = unit * 32 + F.wave * 4;
        if (NG > 0 && NG != 9 && NG != 2) ln_issue_chunk(F, A.WT, 0, 0);
        f32x4 xr[4][8];
        if constexpr (MODE == 0) {
#pragma unroll
            for (int r = 0; r < 4; ++r)
#pragma unroll
                for (int j = 0; j < 8; ++j) { const v2u p = *((const v2u*)(A.Y + (size_t)(row0 + r) * DM) + 64 * j + F.lane); xr[r][j] = (f32x4){bflo(p.x), bfhi(p.x), bflo(p.y), bfhi(p.y)}; }
        } else if constexpr (MODE == 2) {
            v2u xraw[4][8], ya[16], yb[16];
#define LN_LOADY2(Y_, r_) do { _Pragma("unroll") for (int j = 0; j < 8; ++j) { Y_[j] = *((const v2u*)(A.Y + (size_t)(row0 + (r_)) * DM) + 64 * j + F.lane); Y_[8 + j] = *((const v2u*)(A.Y + (size_t)(row0 + (r_) + 1) * DM) + 64 * j + F.lane); } } while (0)
#define LN_ACCY2(Y_, r_) do { _Pragma("unroll") for (int j = 0; j < 8; ++j) { \
                xr[(r_)][j] = xr[(r_)][j] + (f32x4){bflo(Y_[j].x), bfhi(Y_[j].x), bflo(Y_[j].y), bfhi(Y_[j].y)}; \
                xr[(r_) + 1][j] = xr[(r_) + 1][j] + (f32x4){bflo(Y_[8 + j].x), bfhi(Y_[8 + j].x), bflo(Y_[8 + j].y), bfhi(Y_[8 + j].y)}; } } while (0)
#pragma unroll
            for (int r = 0; r < 4; ++r)
#pragma unroll
                for (int j = 0; j < 8; ++j) xraw[r][j] = *((const v2u*)(A.X + (size_t)(row0 + r) * DM) + 64 * j + F.lane);
            LN_LOADY2(ya, 0);
            __builtin_amdgcn_sched_barrier(0);
#pragma unroll
            for (int r = 0; r < 4; ++r)
#pragma unroll
                for (int j = 0; j < 8; ++j) { const v2u p = xraw[r][j]; xr[r][j] = (f32x4){bflo(p.x), bfhi(p.x), bflo(p.y), bfhi(p.y)} * ALPHA; }
            __builtin_amdgcn_sched_barrier(0);
            LN_LOADY2(yb, 2); __builtin_amdgcn_sched_barrier(0); LN_ACCY2(ya, 0); __builtin_amdgcn_sched_barrier(0);
            LN_ACCY2(yb, 2);
            __builtin_amdgcn_sched_barrier(0);
#undef LN_LOADY2
#undef LN_ACCY2
        } else {
            v2u xraw[4][8], ya[16], yb[16];
#define LN_LOADY(Y_, r_) do { _Pragma("unroll") for (int j = 0; j < 8; ++j) { Y_[j] = *((const v2u*)(A.YE + (size_t)(2 * (row0 + (r_))) * DM) + 64 * j + F.lane); Y_[8 + j] = *((const v2u*)(A.YE + (size_t)(2 * (row0 + (r_)) + 1) * DM) + 64 * j + F.lane); } } while (0)
#define LN_ACCY(Y_, r_) do { _Pragma("unroll") for (int j = 0; j < 8; ++j) { \
                xr[(r_)][j].x += __builtin_bit_cast(float, Y_[j].x << 16) + __builtin_bit_cast(float, Y_[8 + j].x << 16); \
                xr[(r_)][j].y += __builtin_bit_cast(float, Y_[j].x & 0xffff0000u) + __builtin_bit_cast(float, Y_[8 + j].x & 0xffff0000u); \
                xr[(r_)][j].z += __builtin_bit_cast(float, Y_[j].y << 16) + __builtin_bit_cast(float, Y_[8 + j].y << 16); \
                xr[(r_)][j].w += __builtin_bit_cast(float, Y_[j].y & 0xffff0000u) + __builtin_bit_cast(float, Y_[8 + j].y & 0xffff0000u); } } while (0)
#pragma unroll
            for (int r = 0; r < 4; ++r)
#pragma unroll
                for (int j = 0; j < 8; ++j) xraw[r][j] = *((const v2u*)(A.X + (size_t)(row0 + r) * DM) + 64 * j + F.lane);
            LN_LOADY(ya, 0);
            __builtin_amdgcn_sched_barrier(0);
#pragma unroll
            for (int r = 0; r < 4; ++r)
#pragma unroll
                for (int j = 0; j < 8; ++j) { const v2u p = xraw[r][j]; xr[r][j] = (f32x4){bflo(p.x), bfhi(p.x), bflo(p.y), bfhi(p.y)} * ALPHA; }
            __builtin_amdgcn_sched_barrier(0);
            LN_LOADY(yb, 1); __builtin_amdgcn_sched_barrier(0); LN_ACCY(ya, 0); __builtin_amdgcn_sched_barrier(0);
            LN_LOADY(ya, 2); __builtin_amdgcn_sched_barrier(0); LN_ACCY(yb, 1); __builtin_amdgcn_sched_barrier(0);
            LN_LOADY(yb, 3); __builtin_amdgcn_sched_barrier(0); LN_ACCY(ya, 2); __builtin_amdgcn_sched_barrier(0);
            LN_ACCY(yb, 3);
            __builtin_amdgcn_sched_barrier(0);
#undef LN_LOADY
#undef LN_ACCY
        }
        f32x4 gg[8], bb8[8];
        {   const __amdgpu_buffer_rsrc_t grs = __builtin_amdgcn_make_buffer_rsrc((void*)A.g, 0, DM * 4, 0x00020000), brs = __builtin_amdgcn_make_buffer_rsrc((void*)A.b, 0, DM * 4, 0x00020000);
#pragma unroll
            for (int j = 0; j < 8; ++j) { gg[j] = __builtin_bit_cast(f32x4, __builtin_amdgcn_raw_buffer_load_b128(grs, F.lane * 16, 1024 * j, 0)); bb8[j] = __builtin_bit_cast(f32x4, __builtin_amdgcn_raw_buffer_load_b128(brs, F.lane * 16, 1024 * j, 0)); } }
        __builtin_amdgcn_sched_barrier(0);
        float rstd[4];
#pragma unroll
        for (int r = 0; r < 4; ++r) {
            float s = 0.f;
#pragma unroll
            for (int j = 0; j < 8; ++j) s += (xr[r][j].x + xr[r][j].y) + (xr[r][j].z + xr[r][j].w);
            const float mu = wave_sum(s) * (1.f / DM); float s2 = 0.f;
#pragma unroll
            for (int j = 0; j < 8; ++j) { xr[r][j] = xr[r][j] - mu; s2 += (xr[r][j].x * xr[r][j].x + xr[r][j].y * xr[r][j].y) + (xr[r][j].z * xr[r][j].z + xr[r][j].w * xr[r][j].w); }
            rstd[r] = 1.f / sqrtf(wave_sum(s2) * (1.f / DM) + LN_EPS);
        }
#pragma unroll
        for (int j = 0; j < 8; ++j) { const f32x4 g4 = gg[j], b4 = bb8[j];
#pragma unroll
            for (int r = 0; r < 4; ++r) { const f32x4 o = xr[r][j] * rstd[r] * g4 + b4; xr[r][j] = o;
                if (A.XF) __builtin_nontemporal_store(o, (f32x4*)(A.XF + (size_t)(row0 + r) * DM) + 64 * j + F.lane);
                if (A.XBo) { v2u p; p.x = pk2(o.x, o.y); p.y = pk2(o.z, o.w); *((v2u*)(A.XBo + (size_t)(row0 + r) * DM) + 64 * j + F.lane) = p; } } }
        if constexpr (NG == 9 || NG == 2) {
            constexpr int NTL = NG == 9 ? 3 : 1, NCOL = NG == 9 ? 72 : 16;
            typedef float f32x16 __attribute__((ext_vector_type(16)));
            constexpr int XP = 4112, CSO = 0, LSO = 32 * XP;
            const bf16* WFb = (const bf16*)A.WT;
            f32x16 ca[NTL];
#pragma unroll
            for (int nt = 0; nt < NTL; ++nt) ca[nt] = f32x16{};
            constexpr int UG = NTL == 3 ? 2 : 8;
            bf16x8 fa[UG][2 * NTL], fb[UG][2 * NTL];
            const __amdgpu_buffer_rsrc_t wrs = __builtin_amdgcn_make_buffer_rsrc((void*)WFb, 0, 2 * 128 * NTL * 1024, 0x00020000);
            const int wv_ = F.lane * 16, ws_ = F.wave * NTL * 1024;
#define LN_LOADF(f, u0) do { _Pragma("unroll") for (int uu = 0; uu < UG; ++uu) { \
                _Pragma("unroll") for (int nt = 0; nt < NTL; ++nt) { f[uu][nt] = __builtin_bit_cast(bf16x8, __builtin_amdgcn_raw_buffer_load_b128(wrs, wv_, ws_ + ((u0) + uu) * 8 * NTL * 1024 + nt * 1024, 0)); \
                    f[uu][NTL + nt] = __builtin_bit_cast(bf16x8, __builtin_amdgcn_raw_buffer_load_b128(wrs, wv_, ws_ + 128 * NTL * 1024 + ((u0) + uu) * 8 * NTL * 1024 + nt * 1024, 0)); } } } while (0)
#define LN_MFMAS(f, u0) do { _Pragma("unroll") for (int uu = 0; uu < UG; ++uu) { const bf16x8 ah = *(const LAS bf16x8*)(xa + (F.wave + 8 * ((u0) + uu)) * 32); \
                _Pragma("unroll") for (int nt = 0; nt < NTL; ++nt) { ca[nt] = __builtin_amdgcn_mfma_f32_32x32x16_bf16(ah, f[uu][nt], ca[nt], 0, 0, 0); ca[nt] = __builtin_amdgcn_mfma_f32_32x32x16_bf16(ah, f[uu][NTL + nt], ca[nt], 0, 0, 0); } } } while (0)
            __syncthreads();
#pragma unroll
            for (int r = 0; r < 4; ++r)
#pragma unroll
                for (int j = 0; j < 8; ++j) { const f32x4 v = xr[r][j]; v2u h; h.x = pk2(v.x, v.y); h.y = pk2(v.z, v.w);
                    *(LAS v2u*)(F.lds + (F.wave * 4 + r) * XP + (256 * j + 4 * F.lane) * 2) = h; }
            LN_LOADF(fa, 0);
            __syncthreads();
            {   const LAS unsigned char* xa = F.lds + (F.lane & 31) * XP + (F.lane >> 5) * 16;
#pragma unroll
                for (int u = 0; u < 16; u += 2 * UG) {
                    LN_LOADF(fb, u + UG);
                    __builtin_amdgcn_sched_barrier(0);
                    LN_MFMAS(fa, u);
                    __builtin_amdgcn_sched_barrier(0);
                    if (u + 2 * UG < 16) LN_LOADF(fa, u + 2 * UG);
                    __builtin_amdgcn_sched_barrier(0);
                    LN_MFMAS(fb, u + UG);
                    __builtin_amdgcn_sched_barrier(0);
                }
            }
#undef LN_LOADF
#undef LN_MFMAS
            __syncthreads();
            {   LAS float* cs = (LAS float*)(F.lds + CSO) + F.wave * (32 * 32 * NTL);
#pragma unroll
                for (int nt = 0; nt < NTL; ++nt)
#pragma unroll
                    for (int r = 0; r < 16; ++r) cs[((r & 3) + 8 * (r >> 2) + 4 * (F.lane >> 5)) * (32 * NTL) + 32 * nt + (F.lane & 31)] = ca[nt][r]; }
            __syncthreads();
            {   LAS float* ls = (LAS float*)(F.lds + LSO);
                for (int idx = F.tid; idx < 32 * NCOL; idx += NTHR) { const int row = idx / NCOL, col = idx % NCOL; float s = 0.f;
#pragma unroll
                    for (int w8 = 0; w8 < 8; ++w8) s += ((const LAS float*)(F.lds + CSO))[w8 * (32 * 32 * NTL) + row * (32 * NTL) + col];
                    if constexpr (NG == 2) A.GLOW[(size_t)(unit * 32 + row) * 16 + col] = s; else ls[row * NCOL + col] = s; } }
            __syncthreads();
            if constexpr (NG == 9) {   const int rr = F.lane >> 4, t = row0 + rr; const LAS float* lr = (const LAS float*)(F.lds + LSO) + (F.wave * 4 + rr) * 72;
                float gl[8]; int gi = 0; float gm = -1e30f;
#pragma unroll
                for (int i = 0; i < 8; ++i) { gl[i] = lr[64 + i] + A.bg[i]; if (gl[i] > gm) { gm = gl[i]; gi = i; } }
                float gs = 0.f;
#pragma unroll
                for (int i = 0; i < 8; ++i) gs += __expf(gl[i] - gm);
                const float grp_p = 1.f / gs;
                float el[8]; int i1 = 0; float m1 = -1e30f;
#pragma unroll
                for (int i = 0; i < 8; ++i) { el[i] = lr[gi * 8 + i] + A.be[gi * 8 + i]; if (el[i] > m1) { m1 = el[i]; i1 = i; } }
                int i2 = 0; float m2 = -1e30f;
#pragma unroll
                for (int i = 0; i < 8; ++i) { if (i != i1 && el[i] > m2) { m2 = el[i]; i2 = i; } }
                const float e2 = __expf(m2 - m1), p1 = 1.f / (1.f + e2), p2 = e2 / (1.f + e2);
                if ((F.lane & 15) == 0) {
                    const int ex1 = gi * 8 + i1, ex2 = gi * 8 + i2;
                    A.TOPE[2 * t] = ex1; A.TOPE[2 * t + 1] = ex2; A.TOPG[2 * t] = grp_p * p1; A.TOPG[2 * t + 1] = grp_p * p2;
                    if (A.CNT) { const unsigned q1 = atomicAdd(&A.CNT[ex1], 1u); A.LIST[ex1 * T + q1] = 2 * t;
                    const unsigned q2 = atomicAdd(&A.CNT[ex2], 1u); A.LIST[ex2 * T + q2] = 2 * t + 1; }
                }
            }
            __syncthreads();
        } else if constexpr (NG > 0) {
            float res[NG];
#pragma unroll
            for (int k = 0; k < NG; ++k) res[k] = 0.f;
#pragma unroll 1
            for (int g = 0; g < NG; ++g) {
                VM_WAIT(); __syncthreads();
                if (g + 1 < NG) ln_issue_chunk(F, A.WT, g + 1, (g + 1) & 1);
                float acc[32];
#pragma unroll
                for (int i = 0; i < 32; ++i) acc[i] = 0.f;
                const LAS f32x4* wb = (const LAS f32x4*)(F.lds + RING_OFF + (g & 1) * 65536) + F.lane;
#pragma unroll
                for (int c = 0; c < 8; ++c) {
#pragma unroll
                    for (int j = 0; j < 8; ++j) { const f32x4 w = wb[c * 512 + 64 * j];
#pragma unroll
                        for (int r = 0; r < 4; ++r) acc[r * 8 + c] += (xr[r][j].x * w.x + xr[r][j].y * w.y) + (xr[r][j].z * w.z + xr[r][j].w * w.w); }
                    __builtin_amdgcn_sched_barrier(0);
                }
                rs32(acc, F.lane);
#pragma unroll
                for (int k = 0; k < NG; ++k) res[k] = (g == k) ? acc[0] : res[k];
            }
            const int rr = F.lane >> 4, cc = (F.lane >> 1) & 7, t = row0 + rr;
            if constexpr (NG == 2) {
                if ((F.lane & 1) == 0) { A.GLOW[(size_t)t * 16 + cc] = res[0]; A.GLOW[(size_t)t * 16 + 8 + cc] = res[1]; }
            } else {
                float gl[8]; int gi = 0; float gm = -1e30f;
#pragma unroll
                for (int i = 0; i < 8; ++i) { gl[i] = __shfl(res[NG - 1], (F.lane & 48) + 2 * i) + A.bg[i]; if (gl[i] > gm) { gm = gl[i]; gi = i; } }
                float gs = 0.f;
#pragma unroll
                for (int i = 0; i < 8; ++i) gs += expf(gl[i] - gm);
                const float grp_p = 1.f / gs;
                float sel = res[0];
#pragma unroll
                for (int i = 1; i < 8; ++i) sel = (gi == i) ? res[i] : sel;
                float el[8]; int i1 = 0; float m1 = -1e30f;
#pragma unroll
                for (int i = 0; i < 8; ++i) { el[i] = __shfl(sel, (F.lane & 48) + 2 * i) + A.be[gi * 8 + i]; if (el[i] > m1) { m1 = el[i]; i1 = i; } }
                int i2 = 0; float m2 = -1e30f;
#pragma unroll
                for (int i = 0; i < 8; ++i) { if (i != i1 && el[i] > m2) { m2 = el[i]; i2 = i; } }
                const float e2 = expf(m2 - m1), p1 = 1.f / (1.f + e2), p2 = e2 / (1.f + e2);
                if ((F.lane & 15) == 0) {
                    const int ex1 = gi * 8 + i1, ex2 = gi * 8 + i2;
                    A.TOPE[2 * t] = ex1; A.TOPE[2 * t + 1] = ex2; A.TOPG[2 * t] = grp_p * p1; A.TOPG[2 * t + 1] = grp_p * p2;
                    if (A.CNT) { const unsigned q1 = atomicAdd(&A.CNT[ex1], 1u); A.LIST[ex1 * T + q1] = 2 * t;
                    const unsigned q2 = atomicAdd(&A.CNT[ex2], 1u); A.LIST[ex2 * T + q2] = 2 * t + 1; }
                }
            }
            __syncthreads();
        }
    }
}


struct MoeArgs { const unsigned* CNT; const int* LIST; const float* TOPG; const bf16* XB; const float* Wg; const float* Wu; const float* Wd; bf16* HID; bf16* YE; unsigned* FLG; };
__device__ __forceinline__ int swz10(int ob) { return ob ^ (((ob >> 9) & 1) << 5); }
template <int MODE, int VAR = 0>
__device__ __forceinline__ void moe_phase(Frame& F, const MoeArgs& A) {
    constexpr int K = MODE == 0 ? DM : EFF, NKT = K / 64, NCH = MODE == 0 ? 2 : 4, NIT = NKT * NCH, NUNITS = NEXP * 4, LDW = MODE == 0 ? EFF : DM, CSTEP = MODE == 0 ? 64 : 128;
    constexpr int ABYTES = 384 * 128, BPITCH = 288, BBYTES = 64 * BPITCH, BOFF = 2 * ABYTES, TOFF = BOFF + 2 * BBYTES;
    static_assert(NIT % 2 == 0 && NKT % 2 == 0, "K-loop unrolled by 2");
    LAS int* pre = (LAS int*)(F.lds + TOFF);
    LAS int* rinfo = pre + 80;
    LAS float* rgate = (LAS float*)(rinfo + 384);
    const int tid = F.tid, lane = F.lane, wid = F.wave, wr = wid >> 1, wc = wid & 1, fr = lane & 15, fq = lane >> 4;
    if (tid == 0) { int s = 0; for (int e = 0; e < NEXP; ++e) { pre[e] = s; s += (int)A.CNT[e]; } pre[NEXP] = s; }
    __syncthreads();
    const int lo = swz10(fr * 64 + fq * 16);
    const int a_q = tid & 7, a_dst = (a_q >> 2) * 24576 + (tid >> 7) * 1024 + swz10(((tid >> 3) & 15) * 64 + (a_q & 3) * 16);
    const int b_g4 = tid & 31, b_kr = tid >> 5;
    const unsigned b_woff = (unsigned)(b_kr * DM + 4 * b_g4);
    const int b_dst = b_kr * BPITCH + (MODE == 1 ? 32 * (2 * (b_g4 >> 3) + (b_g4 & 1)) + 8 * ((b_g4 >> 1) & 3) : b_g4 * 8);
    const int b_rd = (8 * fq + (fr >> 2)) * BPITCH + (fr & 3) * 8 + wc * 128;
    for (int unit = F.vcu; unit < NUNITS; unit += F.G) {
        const int e = unit >> 2, chunk0 = NCH * (unit & 3);
        const int n_e = (int)A.CNT[e], off_e = pre[e];
        const float* wp0;
        if (MODE == 0) { const int nt = (b_g4 >> 2) & 3; wp0 = (nt < 2 ? A.Wg : A.Wu) + (size_t)e * DM * EFF + (size_t)b_kr * EFF + chunk0 * 64 + 32 * (b_g4 >> 4) + 8 * (b_g4 & 3) + 4 * (nt & 1); }
        else wp0 = A.Wd + (size_t)e * EFF * DM + chunk0 * 128;
        if (MODE == 1) {
            if (wid == 0) { unsigned sp = 0;
                while ((unsigned)__builtin_amdgcn_readfirstlane(__hip_atomic_load(A.FLG + 64 * e, __ATOMIC_RELAXED, __HIP_MEMORY_SCOPE_AGENT)) < 4u) { __builtin_amdgcn_s_sleep(2); if (++sp > (1u << 22)) break; }
                __builtin_amdgcn_fence(__ATOMIC_ACQUIRE, "agent");
                asm volatile("s_waitcnt vmcnt(0)" ::: "memory"); }
            __syncthreads();
        }
        for (int p0 = 0; p0 < n_e; p0 += 384) {
            const int nrows = (n_e - p0) < 384 ? (n_e - p0) : 384;
            __syncthreads();
            if (tid < 384) { const int a = tid < nrows ? A.LIST[e * T + p0 + tid] : 0;
                if (MODE == 0) rinfo[tid] = (a >> 1) * (DM * 2); else { rinfo[tid] = a; rgate[tid] = tid < nrows ? A.TOPG[a] : 0.f; } }
            __syncthreads();
            const unsigned aoff1 = (unsigned)(off_e + p0 + (tid >> 3)) * (EFF * 2) + a_q * 16;
            const LAS int* rinfo_t = rinfo + (tid >> 3);
            const __amdgpu_buffer_rsrc_t ars = __builtin_amdgcn_make_buffer_rsrc((void*)(MODE == 0 ? A.XB : A.HID), 0, MODE == 0 ? T * DM * 2 : (2 * T + 512) * EFF * 2, 0x00020000);
            const int ntile = (nrows + 15) >> 4;
            int mtv = (ntile - wr + 3) >> 2; mtv = mtv < 0 ? 0 : (mtv > 6 ? 6 : mtv);
            f32x4 acc[6][4];
#pragma unroll
            for (int m = 0; m < 6; ++m)
#pragma unroll
                for (int n = 0; n < 4; ++n) acc[m][n] = (f32x4){0.f, 0.f, 0.f, 0.f};
            bf16x8 ar[6] = {}; f32x4 br0[4] = {}, br1[4] = {};
#define MOE_LOADA(it) do { if (!(VAR & 1)) _Pragma("unroll") for (int i = 0; i < 6; ++i) { const unsigned ao_ = MODE == 0 ? (unsigned)rinfo_t[64 * i] + a_q * 16 : aoff1 + (unsigned)i * (64u * EFF * 2u); \
                          ar[i] = __builtin_bit_cast(bf16x8, __builtin_amdgcn_raw_buffer_load_b128(ars, ao_, ((it) % NKT) * 128, 0)); } } while (0)
#define MOE_LOADB(R, it) do { const float* wp_ = wp0 + (size_t)((it) % NKT) * 64 * LDW + ((it) / NKT) * CSTEP; if (!(VAR & 2)) _Pragma("unroll") for (int j = 0; j < 4; ++j) R[j] = __builtin_nontemporal_load((const f32x4*)(wp_ + (size_t)j * 16 * LDW + (MODE == 0 ? 0u : b_woff))); } while (0)
#define MOE_WRITEA(buf) do { LAS unsigned char* ab_ = F.lds + (buf) * ABYTES + a_dst; _Pragma("unroll") for (int i = 0; i < 6; ++i) *(LAS bf16x8*)(ab_ + i * 4096) = ar[i]; } while (0)
#define MOE_WRITEB(R, buf) do { LAS unsigned char* bb_ = F.lds + BOFF + (buf) * BBYTES + b_dst; \
                            _Pragma("unroll") for (int j = 0; j < 4; ++j) { v2u w_; w_.x = pk2(R[j].x, R[j].y); w_.y = pk2(R[j].z, R[j].w); *(LAS v2u*)(bb_ + j * 16 * BPITCH) = w_; } } while (0)
#define MOE_COMPUTE(buf) do { const LAS unsigned char* ab = F.lds + (buf) * ABYTES + lo + wr * 1024; \
                const LAS unsigned char* bb = F.lds + BOFF + (buf) * BBYTES + b_rd; \
                _Pragma("unroll") for (int s = 0; s < 2; ++s) { bf16x8 af[6], bfr_[4]; \
                    _Pragma("unroll") for (int n = 0; n < 4; ++n) { const s16x4 l_ = lds_tr16(bb + s * 32 * BPITCH + n * 32), h_ = lds_tr16(bb + s * 32 * BPITCH + n * 32 + 4 * BPITCH); \
                        bfr_[n] = (bf16x8){l_[0], l_[1], l_[2], l_[3], h_[0], h_[1], h_[2], h_[3]}; } \
                    _Pragma("unroll") for (int m = 0; m < 6; ++m) af[m] = *(const LAS bf16x8*)(ab + s * 24576 + m * 4096); \
                    if (!(VAR & 4)) _Pragma("unroll") for (int m = 0; m < 6; ++m) if (m < mtv) { \
                        _Pragma("unroll") for (int n = 0; n < 4; ++n) acc[m][n] = __builtin_amdgcn_mfma_f32_16x16x32_bf16(bfr_[n], af[m], acc[m][n], 0, 0, 0); } } } while (0)
#define MOE_BAR() asm volatile("s_waitcnt lgkmcnt(0)\n\ts_barrier" ::: "memory")
#define MOE_EPI(ci) do { const int chunk = chunk0 + (ci); \
                _Pragma("unroll") for (int m = 0; m < 6; ++m) { const int row = 16 * (wr + 4 * m) + fr; \
                    if (row < nrows) { \
                        if (MODE == 0) { bf16* hp = A.HID + (size_t)(off_e + p0 + row) * EFF + chunk * 64 + 32 * wc + 8 * fq; \
                            const f32x4 g0 = acc[m][0], u0 = acc[m][2], g1 = acc[m][1], u1 = acc[m][3]; \
                            st16_wt(hp, pk2(silu(g0.x) * u0.x, silu(g0.y) * u0.y), pk2(silu(g0.z) * u0.z, silu(g0.w) * u0.w), pk2(silu(g1.x) * u1.x, silu(g1.y) * u1.y), pk2(silu(g1.z) * u1.z, silu(g1.w) * u1.w)); } \
                        else { const float gt = rgate[row]; bf16* yp = A.YE + (size_t)rinfo[row] * DM + chunk * 128 + 64 * wc + 8 * fq; \
                            _Pragma("unroll") for (int np = 0; np < 2; ++np) { const f32x4 y0 = acc[m][2 * np] * gt, y1 = acc[m][2 * np + 1] * gt; v4u o; o.x = pk2(y0.x, y0.y); o.y = pk2(y0.z, y0.w); o.z = pk2(y1.x, y1.y); o.w = pk2(y1.z, y1.w); *(v4u*)(yp + 32 * np) = o; } } } \
                    _Pragma("unroll") for (int n = 0; n < 4; ++n) acc[m][n] = (f32x4){0.f, 0.f, 0.f, 0.f}; } } while (0)
            MOE_LOADA(0); MOE_LOADB(br0, 0); MOE_LOADB(br1, 1);
            MOE_WRITEA(0); MOE_LOADA(1); MOE_WRITEB(br0, 0);
            MOE_BAR();
#pragma unroll 1
            for (int it = 0; it < NIT; it += 2) {
                const int i2 = it + 2 < NIT ? it + 2 : NIT - 1, i3 = it + 3 < NIT ? it + 3 : NIT - 1;
                MOE_LOADB(br0, i2);
                MOE_COMPUTE(0);
                MOE_WRITEA(1); MOE_LOADA(i2); MOE_WRITEB(br1, 1);
                MOE_BAR();
                MOE_LOADB(br1, i3);
                MOE_COMPUTE(1);
                if (NCH > 1 && (it + 1) % NKT == NKT - 1) MOE_EPI((it + 1) / NKT);
                MOE_WRITEA(0); MOE_LOADA(i3); MOE_WRITEB(br0, 0);
                MOE_BAR();
            }
            if (NCH == 1) MOE_EPI(0);
#undef MOE_LOADA
#undef MOE_LOADB
#undef MOE_WRITEA
#undef MOE_WRITEB
#undef MOE_COMPUTE
#undef MOE_BAR
#undef MOE_EPI
        }
        if (MODE == 0) {
            asm volatile("s_waitcnt vmcnt(0)" ::: "memory");
            __syncthreads();
            if (tid == 0 && A.FLG) __hip_atomic_fetch_add(A.FLG + 64 * e, 1u, __ATOMIC_RELAXED, __HIP_MEMORY_SCOPE_AGENT);
        }
    }
}

namespace fox {
typedef short s16x4 __attribute__((ext_vector_type(4)));
typedef float f32x16 __attribute__((ext_vector_type(16)));
typedef unsigned u32x4 __attribute__((ext_vector_type(4)));
constexpr int D = 128, PITCH = 128, OPITCH = DM;
constexpr unsigned KOFF = 16u * T * 128u * 2u, VOFF = 32u * T * 128u * 2u;
constexpr float SCALE = FOX_SCALE;
constexpr float THR = 8.f;
constexpr int NW = 8, QBLK = 32, KVBLK = 64, QB = NW * QBLK;
constexpr int SHM_V = KVBLK * D * 2, SHM_K = KVBLK * D * 2;
constexpr int WS_OFF = 2 * SHM_V + 2 * SHM_K, BIAS_OFF = WS_OFF + NW * 64 * 4;
constexpr int LDS_NEED = BIAS_OFF + 2 * 64 * 4;
#define KSWZ(row, colB) ((row) * 256 + ((colB) ^ (((row) & 7) << 4)))
#define SBAR() __builtin_amdgcn_sched_barrier(0)
__device__ __forceinline__ int v_st(int k, int c) { const int kk = (k & ~0xC) | ((k & 4) << 1) | ((k & 8) >> 1); return ((kk >> 3) * 4 + (c >> 5)) * 512 + ((kk & 7) * 32 + (c & 31)) * 2; }
__device__ __forceinline__ int v_rd_base(int lane) { return ((lane & 3) << 3) | (((lane >> 2) & 3) << 6) | (((lane >> 4) & 1) << 5) | (((lane >> 5) & 1) << 8); }
constexpr int v_rd_off(int d0, int ks, int half) { return d0 * 512 + ks * 4096 + half * 2048; }
__device__ __forceinline__ int crow(int r, int hi) { return (r & 3) + 8 * (r >> 2) + 4 * hi; }
__device__ __forceinline__ unsigned cvtpk(float lo, float hi) { unsigned r; asm volatile("v_cvt_pk_bf16_f32 %0, %1, %2" : "=v"(r) : "v"(lo), "v"(hi)); return r; }
__device__ __forceinline__ bf16x8 load8(const bf16* p) { return *reinterpret_cast<const bf16x8*>(p); }
__device__ __forceinline__ void mask_tile(f32x16& p0, f32x16& p1, int dq, unsigned W) {
    const float NEG = -__builtin_inff();
#pragma unroll
    for (int r = 0; r < 16; ++r) {
        const int c = (r & 3) + 8 * (r >> 2);
        if ((unsigned)(dq - c) >= W) p0[r] = NEG;
        if ((unsigned)(dq - c - 32) >= W) p1[r] = NEG;
    }
}
__device__ __forceinline__ void partialSM(f32x16& p0, f32x16& p1, float& m_reg, float& mn, float& alpha) {
    float pmax = p0[0]; for (int r = 1; r < 16; ++r) pmax = fmaxf(pmax, p0[r]); for (int r = 0; r < 16; ++r) pmax = fmaxf(pmax, p1[r]);
    { auto rr = __builtin_amdgcn_permlane32_swap(__float_as_uint(pmax), __float_as_uint(pmax), false, false);
      pmax = fmaxf(__uint_as_float(rr[0]), __uint_as_float(rr[1])); }
    constexpr float C2 = 1.4426950408889634f * SCALE;
    if (__builtin_expect(__all((pmax - m_reg) * SCALE <= THR), 1)) { mn = m_reg; alpha = 1.f; }
    else { mn = fmaxf(m_reg, pmax); alpha = __builtin_amdgcn_exp2f((m_reg - mn) * C2); m_reg = mn; }
    const float mnL = -mn * C2;
    for (int r = 0; r < 16; ++r) p0[r] = fmaf(p0[r], C2, mnL); for (int r = 0; r < 16; ++r) p1[r] = fmaf(p1[r], C2, mnL);
    for (int r = 0; r < 16; ++r) p0[r] = __builtin_amdgcn_exp2f(p0[r]);
}
__device__ __forceinline__ void finishSM(f32x16& p0, f32x16& p1, float alpha, float& l_reg, bf16x8& pa0, bf16x8& pa1, bf16x8& pa2, bf16x8& pa3) {
    for (int r = 0; r < 16; ++r) p1[r] = __builtin_amdgcn_exp2f(p1[r]);
    float ps = 0; for (int r = 0; r < 16; ++r) ps += p0[r]; for (int r = 0; r < 16; ++r) ps += p1[r];
    { auto rr = __builtin_amdgcn_permlane32_swap(__float_as_uint(ps), __float_as_uint(ps), false, false);
      ps = __uint_as_float(rr[0]) + __uint_as_float(rr[1]); }
    l_reg = l_reg * alpha + ps;
#define PK4(P, B_, OUT) do { unsigned a0 = cvtpk(P[B_+0], P[B_+1]), a1 = cvtpk(P[B_+2], P[B_+3]);                          \
        unsigned b0 = cvtpk(P[B_+4], P[B_+5]), b1 = cvtpk(P[B_+6], P[B_+7]);                                             \
        auto r0 = __builtin_amdgcn_permlane32_swap(a0, b0, false, false); auto r1 = __builtin_amdgcn_permlane32_swap(a1, b1, false, false); \
        u32x4 w = {r0[0], r1[0], r0[1], r1[1]}; OUT = *reinterpret_cast<bf16x8*>(&w); } while (0)
    PK4(p0, 0, pa0); PK4(p0, 8, pa1); PK4(p1, 0, pa2); PK4(p1, 8, pa3);
#undef PK4
}
template <int KB>
__device__ __forceinline__ void qkt(f32x16& p0, f32x16& p1, const char* K_lds, const float* B_lds, int r32, int hi, const bf16x8* qr) {
    const float* bl = B_lds + KB * 64 + 4 * hi;
#pragma unroll
    for (int g = 0; g < 4; ++g) { const f32x4 t = *(const f32x4*)(bl + 8 * g), u = *(const f32x4*)(bl + 32 + 8 * g);
        p0[4 * g + 0] = t.x; p0[4 * g + 1] = t.y; p0[4 * g + 2] = t.z; p0[4 * g + 3] = t.w; p1[4 * g + 0] = u.x; p1[4 * g + 1] = u.y; p1[4 * g + 2] = u.z; p1[4 * g + 3] = u.w; }
    const char* kb[4];
#pragma unroll
    for (int dd = 0; dd < 4; ++dd) kb[dd] = K_lds + KB * SHM_K + KSWZ(r32, (dd * 16 + hi * 8) * 2);
#pragma unroll
    for (int d0 = 0; d0 < 8; ++d0) { const char* a = kb[d0 & 3] + (d0 >> 2) * 128;
        bf16x8 b0 = *reinterpret_cast<const bf16x8*>(a);
        bf16x8 b1 = *reinterpret_cast<const bf16x8*>(a + 32 * 256);
        p0 = __builtin_amdgcn_mfma_f32_32x32x16_bf16(b0, qr[d0], p0, 0, 0, 0);
        p1 = __builtin_amdgcn_mfma_f32_32x32x16_bf16(b1, qr[d0], p1, 0, 0, 0); }
}
template <int VB>
__device__ __forceinline__ void pv_tile(f32x16* o, int vb0, bf16x8 pa0, bf16x8 pa1, bf16x8 pa2, bf16x8 pa3) {
#define TRRD(dst, off) asm volatile("ds_read_b64_tr_b16 %0, %1 offset:%2" : "=&v"(dst) : "v"(vb0), "i"(off) : "memory")
#define PV_D0(d0) do { s16x4 l0, l1, l2, l3, h0, h1, h2, h3; constexpr int b_ = VB * SHM_V + v_rd_off(d0, 0, 0); \
        TRRD(l0, b_); TRRD(h0, b_ + 2048); TRRD(l1, b_ + 4096); TRRD(h1, b_ + 6144); TRRD(l2, b_ + 8192); TRRD(h2, b_ + 10240); TRRD(l3, b_ + 12288); TRRD(h3, b_ + 14336); \
        asm volatile("s_waitcnt lgkmcnt(0)" ::: "memory"); SBAR();   \
        o[d0] = __builtin_amdgcn_mfma_f32_32x32x16_bf16(pa0, (bf16x8){l0[0], l0[1], l0[2], l0[3], h0[0], h0[1], h0[2], h0[3]}, o[d0], 0, 0, 0);   \
        o[d0] = __builtin_amdgcn_mfma_f32_32x32x16_bf16(pa1, (bf16x8){l1[0], l1[1], l1[2], l1[3], h1[0], h1[1], h1[2], h1[3]}, o[d0], 0, 0, 0);   \
        o[d0] = __builtin_amdgcn_mfma_f32_32x32x16_bf16(pa2, (bf16x8){l2[0], l2[1], l2[2], l2[3], h2[0], h2[1], h2[2], h2[3]}, o[d0], 0, 0, 0);   \
        o[d0] = __builtin_amdgcn_mfma_f32_32x32x16_bf16(pa3, (bf16x8){l3[0], l3[1], l3[2], l3[3], h3[0], h3[1], h3[2], h3[3]}, o[d0], 0, 0, 0); } while (0)
    PV_D0(0); PV_D0(1); PV_D0(2); PV_D0(3);
#undef PV_D0
#undef TRRD
}
struct BlockRef { const bf16* KV; bf16* O; const float* Bz; int P0; };
struct Seam { bf16x8 qr[8]; bf16x8 st_v0, st_v1, st_k0, st_k1; float st_b; };
#define VMW() asm volatile("s_waitcnt vmcnt(0)" ::: "memory")
#define VMWN(n) asm volatile("s_waitcnt vmcnt(%0)" :: "i"(n) : "memory")
#define LD8(R, so) __builtin_bit_cast(bf16x8, __builtin_amdgcn_raw_buffer_load_b128(R, voff, (so), 0))
#define SLOAD_H(R, BR, k0) do { const unsigned so_ = (unsigned)(k0) * (PITCH * 2u); \
                         S.st_v0 = LD8(R, so_ + VOFF); S.st_v1 = LD8(R, so_ + VOFF + 32u * PITCH * 2u); \
                         S.st_k0 = LD8(R, so_ + KOFF); S.st_k1 = LD8(R, so_ + KOFF + 32u * PITCH * 2u); \
                         S.st_b = __builtin_bit_cast(float, __builtin_amdgcn_raw_buffer_load_b32(BR, (unsigned)(tid & 63) * 4u, (unsigned)(k0) * 4u, 0)); } while (0)
#define QLOAD(R, P0_) do { const unsigned qso_ = (unsigned)((P0_) + wid * QBLK) * (PITCH * 2u); _Pragma("unroll") for (int d0 = 0; d0 < 8; ++d0) \
                         S.qr[d0] = __builtin_bit_cast(bf16x8, __builtin_amdgcn_raw_buffer_load_b128(R, qvoff, qso_ + d0 * 32, 0)); } while (0)
#define MKRS(ref) __builtin_amdgcn_make_buffer_rsrc((void*)(ref).KV, 0, (unsigned)((size_t)T * NQKV * 2), 0x00020000)
#define MKBRS(ref) __builtin_amdgcn_make_buffer_rsrc((void*)(ref).Bz, 0, T * 4, 0x00020000)
#define SWRITE_HK(bf) do { *(bf16x8*)(K_lds + (bf) * SHM_K + kws) = S.st_k0; *(bf16x8*)(K_lds + (bf) * SHM_K + kws + 32 * 256) = S.st_k1; if (tid < 64) B_lds[(bf) * 64 + tid] = S.st_b; } while (0)
#define SWRITE_HV(bf) do { *(bf16x8*)(V_lds + (bf) * SHM_V + vst0) = S.st_v0; *(bf16x8*)(V_lds + (bf) * SHM_V + vst1) = S.st_v1; } while (0)
#define SWRITE_H(bf) do { SWRITE_HV(bf); SWRITE_HK(bf); } while (0)
__device__ __forceinline__ void prime(const BlockRef& cur, char* lds, Seam& S) {
    const int tid = threadIdx.x, wid = __builtin_amdgcn_readfirstlane(tid >> 6), lane = tid & 63, r32 = lane & 31, hi = lane >> 5;
    const int sr = tid >> 4, sc = (tid & 15) * 8, kws = KSWZ(sr, sc * 2); char* K_lds = lds + 2 * SHM_V; float* B_lds = (float*)(lds + BIAS_OFF);
    const unsigned voff = (unsigned)(sr * PITCH + sc) * 2u, qvoff = (unsigned)(r32 * PITCH + hi * 8) * 2u;
    const __amdgpu_buffer_rsrc_t rs = MKRS(cur), brs = MKBRS(cur);
    QLOAD(rs, cur.P0);
    SLOAD_H(rs, brs, 0); VMW(); SWRITE_HK(0);
    __syncthreads();
}
__device__ __forceinline__ void block(const BlockRef& cur, const BlockRef& nxt, char* lds, Seam& S) {
    const int tid = threadIdx.x, wid = __builtin_amdgcn_readfirstlane(tid >> 6), lane = tid & 63, r32 = lane & 31, hi = lane >> 5;
    const int W = T;
    const int j_hi = (cur.P0 + QB - 1) / KVBLK + 1;
    const int NT = j_hi;
    const int kbn = 0;
    const int qlo = cur.P0 + wid * QBLK, qm = qlo + r32 - 4 * hi;
    char* V_lds = lds; char* K_lds = lds + 2 * SHM_V; float* B_lds = (float*)(lds + BIAS_OFF);
    float* ws = (float*)(lds + WS_OFF) + wid * 64; float* li_l = ws, * al_l = ws + 32;
    float m_reg = -1e30f, l_reg = 0; f32x16 o[4] = {};
    const int sr = tid >> 4, sc = (tid & 15) * 8, vst0 = v_st(sr, sc), vst1 = v_st(32 + sr, sc), kws = KSWZ(sr, sc * 2);
    const int vb0 = (int)(uintptr_t)V_lds + v_rd_base(lane);
    const unsigned voff = (unsigned)(sr * PITCH + sc) * 2u, qvoff = (unsigned)(r32 * PITCH + hi * 8) * 2u;
    const __amdgpu_buffer_rsrc_t rs = MKRS(cur), brs = MKBRS(cur);
#define RESC(a) do { if (__any((a) < 1.f)) { if (hi == 0) al_l[r32] = (a); asm volatile("s_waitcnt lgkmcnt(0)" ::: "memory");              \
                     for (int d_ = 0; d_ < 4; ++d_) for (int r = 0; r < 16; ++r) o[d_][r] *= al_l[crow(r, hi)]; } } while (0)
#define KBASE(t) ((t) * KVBLK)
#define MASKT(P0_, P1_, t) do { const int kb_ = KBASE(t); if (kb_ + KVBLK - 1 > qlo) mask_tile(P0_, P1_, qm - kb_, (unsigned)W); } while (0)
    constexpr int NQL = 8;
#define SEAM_K0() do { VMWN(NQL); SWRITE_HK(0); SBAR(); } while (0)
    f32x16 pA0, pA1, pB0, pB1; float mnA, mnB, alA, alB; bf16x8 pa0, pa1, pa2, pa3;
    SWRITE_HV(0); SBAR();
    if (NT > 1) { SLOAD_H(rs, brs, KBASE(1)); }
    SBAR(); qkt<0>(pA0, pA1, K_lds, B_lds, r32, hi, S.qr);
    MASKT(pA0, pA1, 0); partialSM(pA0, pA1, m_reg, mnA, alA);
    if (NT > 1) { VMW(); SWRITE_H(1); }
    __syncthreads();
#define HALF_STEP(PX0, PX1, mnX, alX, PY0, PY1, alY, t, KB, VB, SB) do {                                                      \
        SBAR(); qkt<KB>(PX0, PX1, K_lds, B_lds, r32, hi, S.qr);                                             \
        finishSM(PY0, PY1, alY, l_reg, pa0, pa1, pa2, pa3); SBAR();                                                           \
        if ((t) + 1 < NT) { SLOAD_H(rs, brs, KBASE((t) + 1)); SBAR(); }                                               \
        pv_tile<VB>(o, vb0, pa0, pa1, pa2, pa3); MASKT(PX0, PX1, (t)); partialSM(PX0, PX1, m_reg, mnX, alX);                                        \
        __syncthreads();                                                                                                      \
        if ((t) + 1 < NT) { VMW(); SWRITE_H(SB); }                                                                          \
        RESC(alX); __syncthreads(); } while (0)
    for (int t = 1; t + 1 < NT; t += 2) {
        HALF_STEP(pB0, pB1, mnB, alB, pA0, pA1, alA, t, 1, 0, 0);
        HALF_STEP(pA0, pA1, mnA, alA, pB0, pB1, alB, t + 1, 0, 1, 1);
    }
    const bool even = (NT & 1) == 0;
    if (even) { SBAR(); qkt<1>(pB0, pB1, K_lds, B_lds, r32, hi, S.qr); SBAR(); }
    { const __amdgpu_buffer_rsrc_t nrs = MKRS(nxt), nbrs = MKBRS(nxt);
      SLOAD_H(nrs, nbrs, kbn); SBAR();
      QLOAD(nrs, nxt.P0); }
    SBAR();
    finishSM(pA0, pA1, alA, l_reg, pa0, pa1, pa2, pa3); SBAR();
    pv_tile<0>(o, vb0, pa0, pa1, pa2, pa3);
    if (even) { MASKT(pB0, pB1, NT - 1); partialSM(pB0, pB1, m_reg, mnB, alB); __syncthreads(); RESC(alB);
        finishSM(pB0, pB1, alB, l_reg, pa0, pa1, pa2, pa3); SBAR(); pv_tile<1>(o, vb0, pa0, pa1, pa2, pa3); }
    SBAR(); SEAM_K0();
    if (hi == 0) li_l[r32] = l_reg; asm volatile("s_waitcnt lgkmcnt(0)" ::: "memory");
    float rli[16];
#pragma unroll
    for (int r = 0; r < 16; ++r) rli[r] = __builtin_amdgcn_rcpf(li_l[crow(r, hi)]);
    bf16* Ow = cur.O + (size_t)(wid * QBLK) * OPITCH;
#pragma unroll
    for (int r = 0; r < 16; ++r) { const int orow = crow(r, hi);
#pragma unroll
        for (int d0 = 0; d0 < 4; ++d0) { const float v = o[d0][r] * rli[r];
            const float vn = __shfl_xor(v, 1);
            const unsigned pk_ = cvtpk(v, vn), pk2_ = (unsigned)__shfl_xor((int)pk_, 2);
            if ((r32 & 3) == 0) { v2u w_; w_.x = pk_; w_.y = pk2_; *(v2u*)(Ow + (size_t)orow * OPITCH + d0 * 32 + r32) = w_; } } }
    __syncthreads();
#undef RESC
#undef KBASE
#undef MASKT
#undef SEAM_K0
#undef HALF_STEP
}
#undef VMW
#undef VMWN
#undef LD8
#undef QLOAD
#undef MKRS
#undef MKBRS
#undef SLOAD_H
#undef SWRITE_HK
#undef SWRITE_HV
#undef SWRITE_H
__device__ __forceinline__ BlockRef make_ref(const bf16* QKV, const float* CB, bf16* O, int h, int qb) {
    BlockRef r; r.KV = QKV + (size_t)h * T * D; r.O = O + (size_t)(qb * QB) * OPITCH + h * D; r.Bz = CB + (size_t)h * T; r.P0 = qb * QB; return r;
}
__device__ __forceinline__ void phase(char* lds, const bf16* QKV, const float* CB, bf16* O, int first, int stride) {
    constexpr int NQB = T / QB, NX = NQB / 2, TOTAL = FOX_H * NX;
    int L = first; if (L >= TOTAL) return;
    int pass = 0;
    BlockRef cur = make_ref(QKV, CB, O, L / NX, L % NX);
    Seam S;
    prime(cur, lds, S);
    for (;;) {
        const bool more_pass = pass == 0, more_item = L + stride < TOTAL, last = !more_pass && !more_item;
        int Ln = L, passn = pass + 1;
        if (!more_pass) { passn = 0; Ln = more_item ? L + stride : L; }
        const int hn = Ln / NX, xn = Ln % NX;
        const BlockRef nxt = last ? cur : make_ref(QKV, CB, O, hn, passn ? NQB - 1 - xn : xn);
        block(cur, nxt, lds, S);
        if (last) break;
        cur = nxt; pass = passn; L = Ln;
    }
}
#undef KSWZ
#undef SBAR
}


struct GlaBufs { bf16* QT; bf16* KT; bf16* QI; bf16* KET; bf16* VT; float* DL; bf16* OI; float* SE; float* PE; bf16* OI2; bf16* S0T; float* DPOS; };
constexpr int GLA_G = 16, GLA_GC = GLA_NCH / GLA_G;
__device__ __forceinline__ void gla_prep(Frame& F, const bf16* QKV, const float* GLOW, const float* w_up, const float* b_gate, const GlaBufs& B) {
    LAS float* glow_s = (LAS float*)(F.lds);
    LAS float* bcum = (LAS float*)(F.lds + 4096);
    LAS unsigned char* keR = F.lds + 69632;
    LAS unsigned char* vR = F.lds + 106496;
    const int tid = F.tid, c = tid & 255, half = tid >> 8, lane = F.lane;
    const int tr_rd = (8 * (lane >> 4) + ((lane >> 2) & 3)) * 576 + (4 * (lane & 3)) * 2;
    const int tr_col = lane & 15, tr_tok = 8 * (lane >> 4);
    for (int unit = F.vcu; unit < GLA_NCH * GLA_H; unit += F.G) {
        const int n = unit >> 2, h = unit & 3, t0 = n * GLA_C;
        __syncthreads();
        if (tid < 256) *((LAS f32x4*)glow_s + tid) = *((const f32x4*)(GLOW + (size_t)t0 * 16) + tid);
        float w[16];
#pragma unroll
        for (int r = 0; r < 16; ++r) w[r] = w_up[r * 1024 + h * 256 + c];
        const float bg = b_gate[h * 256 + c];
        v4u qv[4], kv[4], vv[2][4];
#pragma unroll
        for (int it = 0; it < 4; ++it) { const int id = tid + 512 * it, t = id >> 5, c8 = (id & 31) * 8; const size_t ro = (size_t)(t0 + t) * NQKV + h * 256 + c8;
            qv[it] = *(const v4u*)(QKV + ro); kv[it] = *(const v4u*)(QKV + ro + 1024); }
#pragma unroll
        for (int hv = 0; hv < 2; ++hv)
#pragma unroll
            for (int it = 0; it < 4; ++it) { const int id = tid + 512 * it, t = id >> 5, d8 = (id & 31) * 8; vv[hv][it] = *(const v4u*)(QKV + (size_t)(t0 + t) * NQKV + 2048 + h * 512 + hv * 256 + d8); }
        __syncthreads();
        { float cum = 0.f;
#pragma unroll 4
          for (int i = 0; i < 32; ++i) { const int t = half * 32 + i; float z = bg;
              const LAS f32x4* gp = (const LAS f32x4*)(glow_s + t * 16);
#pragma unroll
              for (int q = 0; q < 4; ++q) { const f32x4 g4 = gp[q]; z += g4.x * w[4 * q] + g4.y * w[4 * q + 1] + g4.z * w[4 * q + 2] + g4.w * w[4 * q + 3]; }
              const float ls = z >= 0.f ? -__logf(1.f + __expf(-z)) : z - __logf(1.f + __expf(z));
              cum += ls * (1.f / 16.f); bcum[t * 256 + c] = cum; } }
        __syncthreads();
        if (half == 1) { const float add = bcum[31 * 256 + c];
#pragma unroll 4
            for (int i = 0; i < 32; ++i) bcum[(32 + i) * 256 + c] += add; }
        __syncthreads();
        if (half == 0) B.DL[(size_t)(h * GLA_NCH + n) * 256 + c] = __expf(bcum[63 * 256 + c]);
#pragma unroll
        for (int it = 0; it < 4; ++it) {
            const int id = tid + 512 * it, t = id >> 5, c8 = (id & 31) * 8;
            float bb[8], br_[8], bl[8];
            { const f32x4 a0_ = *(const LAS f32x4*)(bcum + t * 256 + c8), a1_ = *(const LAS f32x4*)(bcum + t * 256 + c8 + 4);
              const f32x4 r0_ = *(const LAS f32x4*)(bcum + 31 * 256 + c8), r1_ = *(const LAS f32x4*)(bcum + 31 * 256 + c8 + 4);
              const f32x4 l0_ = *(const LAS f32x4*)(bcum + 63 * 256 + c8), l1_ = *(const LAS f32x4*)(bcum + 63 * 256 + c8 + 4);
#pragma unroll
              for (int j = 0; j < 4; ++j) { bb[j] = a0_[j]; bb[4 + j] = a1_[j]; br_[j] = r0_[j]; br_[4 + j] = r1_[j]; bl[j] = l0_[j]; bl[4 + j] = l1_[j]; } }
            float qf[8], kf[8];
#pragma unroll
            for (int j = 0; j < 4; ++j) { qf[2 * j] = bflo(qv[it][j]) * 0.0625f; qf[2 * j + 1] = bfhi(qv[it][j]) * 0.0625f; kf[2 * j] = bflo(kv[it][j]); kf[2 * j + 1] = bfhi(kv[it][j]); }
            float qt[8], kt[8], qi[8], ke[8];
#pragma unroll
            for (int j = 0; j < 8; ++j) { const float e1 = __expf(bb[j] - br_[j]), e2 = __expf(bb[j]);
                qt[j] = qf[j] * e1; kt[j] = kf[j] * __builtin_amdgcn_rcpf(e1); qi[j] = qf[j] * e2; ke[j] = kf[j] * __expf(bl[j] - bb[j]); }
            const size_t oo = (size_t)(t0 + t) * 1024 + h * 256;
            { v4u o; o.x = pk2(qt[0], qt[1]); o.y = pk2(qt[2], qt[3]); o.z = pk2(qt[4], qt[5]); o.w = pk2(qt[6], qt[7]); *(v4u*)(B.QT + oo + c8) = o; }
            { v4u o; o.x = pk2(kt[0], kt[1]); o.y = pk2(kt[2], kt[3]); o.z = pk2(kt[4], kt[5]); o.w = pk2(kt[6], kt[7]); *(v4u*)(B.KT + oo + c8) = o; }
            {
                const int kk = c8 & 31, p0 = (c8 & ~31) + 8 * ((kk >> 2) & 3) + 4 * (kk >> 4);
                v2u o0, o1; o0.x = pk2(qi[0], qi[1]); o0.y = pk2(qi[2], qi[3]); o1.x = pk2(qi[4], qi[5]); o1.y = pk2(qi[6], qi[7]);
                *(v2u*)(B.QI + oo + p0) = o0; *(v2u*)(B.QI + oo + p0 + 8) = o1; }
            { v4u o; o.x = pk2(ke[0], ke[1]); o.y = pk2(ke[2], ke[3]); o.z = pk2(ke[4], ke[5]); o.w = pk2(ke[6], ke[7]); *(LAS v4u*)(keR + t * 576 + c8 * 2) = o; }
        }
#pragma unroll
        for (int it = 0; it < 4; ++it) { const int id = tid + 512 * it, t = id >> 5, d8 = (id & 31) * 8; *(LAS v4u*)(vR + t * 576 + d8 * 2) = vv[0][it]; }
        __syncthreads();
#define GP_TROUT(SRC, DST) do { _Pragma("unroll") for (int st = 0; st < 4; ++st) { const int step = F.wave * 4 + st, cb = (step >> 1) * 16, tb = (step & 1) * 32; \
            const s16x4 l_ = lds_tr16((SRC) + tb * 576 + cb * 2 + tr_rd), h_ = lds_tr16((SRC) + (tb + 4) * 576 + cb * 2 + tr_rd); \
            *(bf16x8*)((DST) + (size_t)(cb + tr_col) * 64 + tb + tr_tok) = (bf16x8){l_[0], l_[1], l_[2], l_[3], h_[0], h_[1], h_[2], h_[3]}; } } while (0)
#define GP_TROUTF(SRC, DSTF, sl0) do { _Pragma("unroll") for (int st = 0; st < 4; ++st) { const int step = F.wave * 4 + st, cb = (step >> 1) * 16, tb = (step & 1) * 32; \
            const s16x4 l_ = lds_tr16((SRC) + tb * 576 + cb * 2 + tr_rd), h_ = lds_tr16((SRC) + (tb + 4) * 576 + cb * 2 + tr_rd); \
            *(bf16x8*)((DSTF) + ((size_t)(((sl0) + (step >> 1)) * 2 + (step & 1)) * 64 + lane) * 8) = (bf16x8){l_[0], l_[1], l_[2], l_[3], h_[0], h_[1], h_[2], h_[3]}; } } while (0)
        GP_TROUT(keR, B.KET + (size_t)(h * GLA_NCH + n) * 256 * 64);
        GP_TROUTF(vR, B.VT + (size_t)(h * GLA_NCH + n) * 512 * 64, 0);
        __syncthreads();
#pragma unroll
        for (int it = 0; it < 4; ++it) { const int id = tid + 512 * it, t = id >> 5, d8 = (id & 31) * 8; *(LAS v4u*)(vR + t * 576 + d8 * 2) = vv[1][it]; }
        __syncthreads();
        GP_TROUTF(vR, B.VT + (size_t)(h * GLA_NCH + n) * 512 * 64, 16);
#undef GP_TROUTF
#undef GP_TROUT
    }
}
constexpr int GS_QI = 0, GS_KET = 64 * 528, GS_DL = GS_KET + 256 * 144, GS_BUF = GS_DL + 1024;
template <bool CORR>
__device__ __forceinline__ void gla_scan(Frame& F, const GlaBufs& B) {
    const int tid = F.tid, lane = F.lane, wid = F.wave, fr = lane & 15, fq = lane >> 4;
    for (int unit = F.vcu; unit < GLA_G * GLA_H * 8; unit += F.G) {
        const int g = unit >> 5, h = (unit >> 3) & 3, sg = unit & 7;
        if (CORR && g == 0) continue;
        const int n0 = g * GLA_GC, n1 = n0 + GLA_GC;
        __syncthreads();
#define GS_BAR() asm volatile("s_waitcnt lgkmcnt(0)\n\ts_barrier" ::: "memory")
        if (wid >= 4) {
            const int lt = tid - 256;
            v4u ra[17], rb[17];
            f32x4 pacc = (f32x4){1.f, 1.f, 1.f, 1.f};
#define GL_LOAD(R, n_) do { const int nn_ = (n_) < n1 ? (n_) : n1 - 1; \
                _Pragma("unroll") for (int i = 0; i < 8; ++i) { const int id = lt + 256 * i; R[i] = *(const v4u*)(B.QI + (size_t)(nn_ * GLA_C + (id >> 5)) * 1024 + h * 256 + (id & 31) * 8); } \
                if (!CORR) { _Pragma("unroll") for (int i = 0; i < 8; ++i) { const int id = lt + 256 * i; R[8 + i] = *(const v4u*)(B.KET + (size_t)(h * GLA_NCH + nn_) * 256 * 64 + (size_t)id * 8); } } \
                R[16] = *(const v4u*)(B.DL + (size_t)(h * GLA_NCH + nn_) * 256 + (lt & 63) * 4); } while (0)
#define GL_WRITE(R, buf) do { LAS unsigned char* bp_ = F.lds + (buf) * GS_BUF; \
                _Pragma("unroll") for (int i = 0; i < 8; ++i) { const int id = lt + 256 * i; *(LAS v4u*)(bp_ + GS_QI + (id >> 5) * 528 + (id & 31) * 16) = R[i]; } \
                if (!CORR) { _Pragma("unroll") for (int i = 0; i < 8; ++i) { const int id = lt + 256 * i; *(LAS v4u*)(bp_ + GS_KET + (id >> 3) * 144 + (id & 7) * 16) = R[8 + i]; } } \
                if (lt < 64) *(LAS v4u*)(bp_ + GS_DL + lt * 16) = R[16]; } while (0)
            GL_LOAD(ra, n0); GL_WRITE(ra, 0); pacc = pacc * __builtin_bit_cast(f32x4, ra[16]); GL_LOAD(ra, n0 + 1); GL_LOAD(rb, n0 + 2);
            GS_BAR();
#pragma unroll 1
            for (int n = n0; n < n1; n += 2) {
                GL_WRITE(ra, 1); pacc = pacc * __builtin_bit_cast(f32x4, ra[16]); GL_LOAD(ra, n + 3);
                GS_BAR();
                GL_WRITE(rb, 0); if (n + 2 < n1) pacc = pacc * __builtin_bit_cast(f32x4, rb[16]); GL_LOAD(rb, n + 4);
                GS_BAR();
            }
            if (!CORR && sg == 0 && lt < 64) *(f32x4*)(B.PE + (size_t)(g * GLA_H + h) * 256 + lt * 4) = pacc;
#undef GL_LOAD
#undef GL_WRITE
        } else {
            const int slice = sg * 4 + wid;
            f32x4 S[16];
#pragma unroll
            for (int i = 0; i < 16; ++i) S[i] = (f32x4){0.f, 0.f, 0.f, 0.f};
            if (CORR) {
                f32x4 pA[8], sA[8], pB[8], sB[8];
#define GC_LOAD(P_, S_, gp_, i0) do { const float* pe = B.PE + (size_t)((gp_) * GLA_H + h) * 256 + 4 * fq; const float* se = B.SE + ((size_t)(((gp_) * GLA_H + h) * 32 + slice) * 16 * 64 + lane) * 4; \
                    _Pragma("unroll") for (int i = 0; i < 8; ++i) { P_[i] = *(const f32x4*)(pe + 16 * ((i0) + i)); S_[i] = *(const f32x4*)(se + (size_t)((i0) + i) * 256); } } while (0)
                GC_LOAD(pA, sA, 0, 0); GC_LOAD(pB, sB, 0, 8);
#pragma unroll 1
                for (int gp = 0; gp < g; ++gp) { const int gq = gp + 1 < g ? gp + 1 : gp;
#pragma unroll
                    for (int i = 0; i < 8; ++i) S[i] = S[i] * pA[i] + sA[i];
                    GC_LOAD(pA, sA, gq, 0);
#pragma unroll
                    for (int i = 0; i < 8; ++i) S[8 + i] = S[8 + i] * pB[i] + sB[i];
                    GC_LOAD(pB, sB, gq, 8);
                }
#undef GC_LOAD
            }
            const bf16* vtp = B.VT + ((size_t)(h * GLA_NCH) * 512 + slice * 16 + fr) * 64 + 8 * fq;
            bf16x8 vn0 = *(const bf16x8*)(vtp + (size_t)n0 * 512 * 64), vn1 = *(const bf16x8*)(vtp + (size_t)n0 * 512 * 64 + 32);
            bf16* const OO = CORR ? B.OI2 : B.OI;
            GS_BAR();
#pragma unroll 1
            for (int n = n0; n < n1; ++n) {
                const LAS unsigned char* bp = F.lds + ((n - n0) & 1) * GS_BUF;
                const bf16x8 v0 = vn0, v1 = vn1;
                if (!CORR) { const int nn = n + 1 < n1 ? n + 1 : n; vn0 = *(const bf16x8*)(vtp + (size_t)nn * 512 * 64); vn1 = *(const bf16x8*)(vtp + (size_t)nn * 512 * 64 + 32); }
                bf16x8 Sb[8];
#pragma unroll
                for (int s = 0; s < 8; ++s) { v4u wv; wv.x = pk2(S[2 * s].x, S[2 * s].y); wv.y = pk2(S[2 * s].z, S[2 * s].w); wv.z = pk2(S[2 * s + 1].x, S[2 * s + 1].y); wv.w = pk2(S[2 * s + 1].z, S[2 * s + 1].w); Sb[s] = __builtin_bit_cast(bf16x8, wv); }
                f32x4 oacc[4];
#pragma unroll
                for (int m = 0; m < 4; ++m) oacc[m] = (f32x4){0.f, 0.f, 0.f, 0.f};
#define GS_SB() __builtin_amdgcn_sched_barrier(0)
#define GS_LQ(R, s0) do { _Pragma("unroll") for (int m = 0; m < 4; ++m) R[m] = *(const LAS bf16x8*)(bp + GS_QI + (16 * m + fr) * 528 + (s0) * 64 + fq * 16); } while (0)
#define GS_MM(R, s0) do { _Pragma("unroll") for (int m = 0; m < 4; ++m) oacc[m] = __builtin_amdgcn_mfma_f32_16x16x32_bf16(Sb[(s0)], R[m], oacc[m], 0, 0, 0); } while (0)
                {   bf16x8 qa[4], qb[4], qc[4];
                    GS_LQ(qa, 0); GS_LQ(qb, 1); GS_LQ(qc, 2); GS_SB();
                    GS_MM(qa, 0); GS_SB(); GS_LQ(qa, 3); GS_SB();
                    GS_MM(qb, 1); GS_SB(); GS_LQ(qb, 4); GS_SB();
                    GS_MM(qc, 2); GS_SB(); GS_LQ(qc, 5); GS_SB();
                    GS_MM(qa, 3); GS_SB(); GS_LQ(qa, 6); GS_SB();
                    GS_MM(qb, 4); GS_SB(); GS_LQ(qb, 7); GS_SB();
                    GS_MM(qc, 5); GS_SB();
                    GS_MM(qa, 6); GS_MM(qb, 7); GS_SB(); }
#pragma unroll
                for (int m = 0; m < 4; ++m) { v2u ov; ov.x = pk2(oacc[m].x, oacc[m].y); ov.y = pk2(oacc[m].z, oacc[m].w); *(v2u*)(OO + (size_t)(n * GLA_C + 16 * m + fr) * DM + h * 512 + slice * 16 + 4 * fq) = ov; }
                if (CORR) {
#pragma unroll
                    for (int i = 0; i < 16; ++i) S[i] = S[i] * *(const LAS f32x4*)(bp + GS_DL + (16 * i + 4 * fq) * 4);
                } else {
#define GS_LK(R, D_, i0) do { _Pragma("unroll") for (int ii = 0; ii < 2; ++ii) { D_[ii] = *(const LAS f32x4*)(bp + GS_DL + (16 * ((i0) + ii) + 4 * fq) * 4); \
                    R[2 * ii] = *(const LAS bf16x8*)(bp + GS_KET + (16 * ((i0) + ii) + fr) * 144 + fq * 16); R[2 * ii + 1] = *(const LAS bf16x8*)(bp + GS_KET + (16 * ((i0) + ii) + fr) * 144 + 64 + fq * 16); } } while (0)
#define GS_UP(R, D_, i0) do { _Pragma("unroll") for (int ii = 0; ii < 2; ++ii) { S[(i0) + ii] = S[(i0) + ii] * D_[ii]; \
                    S[(i0) + ii] = __builtin_amdgcn_mfma_f32_16x16x32_bf16(R[2 * ii], v0, S[(i0) + ii], 0, 0, 0); S[(i0) + ii] = __builtin_amdgcn_mfma_f32_16x16x32_bf16(R[2 * ii + 1], v1, S[(i0) + ii], 0, 0, 0); } } while (0)
                {   bf16x8 ka[4], kb[4], kc[4]; f32x4 da[2], db[2], dc[2];
                    GS_LK(ka, da, 0); GS_LK(kb, db, 2); GS_LK(kc, dc, 4); GS_SB();
                    GS_UP(ka, da, 0); GS_SB(); GS_LK(ka, da, 6); GS_SB();
                    GS_UP(kb, db, 2); GS_SB(); GS_LK(kb, db, 8); GS_SB();
                    GS_UP(kc, dc, 4); GS_SB(); GS_LK(kc, dc, 10); GS_SB();
                    GS_UP(ka, da, 6); GS_SB(); GS_LK(ka, da, 12); GS_SB();
                    GS_UP(kb, db, 8); GS_SB(); GS_LK(kb, db, 14); GS_SB();
                    GS_UP(kc, dc, 10); GS_SB();
                    GS_UP(ka, da, 12); GS_UP(kb, db, 14); GS_SB(); }
#undef GS_LK
#undef GS_UP
                }
#undef GS_SB
#undef GS_LQ
#undef GS_MM
                GS_BAR();
            }
            if (!CORR) {
                float* se = B.SE + ((size_t)((g * GLA_H + h) * 32 + slice) * 16 * 64 + lane) * 4;
#pragma unroll
                for (int i = 0; i < 16; ++i) *(f32x4*)(se + (size_t)i * 256) = S[i];
            }
        }
#undef GS_BAR
    }
}
__device__ __forceinline__ void glds16(const void* gsrc, unsigned lds_dst) { unsigned keep;
    asm volatile("s_mov_b32 %0, m0\n\ts_mov_b32 m0, %2\n\ts_nop 0\n\tglobal_load_lds_dwordx4 %1, off\n\ts_mov_b32 m0, %0" : "=&s"(keep) : "v"(gsrc), "s"(lds_dst) : "memory"); }
constexpr int GS2_QI = 0, GS2_KET = 32 * 1056, GS2_DL = GS2_KET + 32 * 1088, GS2_BUF = GS2_DL + 1024;
__device__ __forceinline__ void gla_scan8(Frame& F, const GlaBufs& B) {
    const int lane = F.lane, wid = F.wave, fr = lane & 15, fq = lane >> 4;
    const unsigned lds0 = (unsigned)(size_t)F.lds;
    const int qrd = (fr >> 1) * 1056 + (fr & 1) * 512 + (fq ^ (fr & 1)) * 16;
    const int krd = (fr >> 3) * 1088 + (fr & 7) * 128 + (fq ^ ((fr & 7) >> 1)) * 16;
    for (int unit = F.vcu; unit < GLA_G * GLA_H * 4; unit += F.G) {
        const int g = unit >> 4, h = (unit >> 2) & 3, slice = (unit & 3) * 8 + wid;
        const int n0 = g * GLA_GC, n1 = n0 + GLA_GC;
        __syncthreads();
#define GS_BAR() asm volatile("s_waitcnt lgkmcnt(0)\n\ts_barrier" ::: "memory")
#define GS8_DMA(n_, b_) do { const int nn_ = (n_) < n1 ? (n_) : n1 - 1; const unsigned lb_ = lds0 + (b_) * GS2_BUF; \
            _Pragma("unroll") for (int i = 0; i < 4; ++i) { const int pc = wid + 8 * i, rl = lane >> 5, row = 2 * pc + rl, c = (lane & 31) ^ rl; \
                glds16(B.QI + (size_t)(nn_ * GLA_C + row) * 1024 + h * 256 + c * 8, (unsigned)__builtin_amdgcn_readfirstlane((int)(lb_ + GS2_QI + pc * 1056))); } \
            _Pragma("unroll") for (int i = 0; i < 4; ++i) { const int pc = wid + 8 * i, rl = lane >> 3, row = 8 * pc + rl, c = (lane & 7) ^ (rl >> 1); \
                glds16(B.KET + (size_t)(h * GLA_NCH + nn_) * 256 * 64 + row * 64 + c * 8, (unsigned)__builtin_amdgcn_readfirstlane((int)(lb_ + GS2_KET + pc * 1088))); } \
            if (wid == 0) glds16(B.DL + (size_t)(h * GLA_NCH + nn_) * 256 + lane * 4, (unsigned)__builtin_amdgcn_readfirstlane((int)(lb_ + GS2_DL))); } while (0)
        f32x4 S[16];
#pragma unroll
        for (int i = 0; i < 16; ++i) S[i] = (f32x4){0.f, 0.f, 0.f, 0.f};
        f32x4 pacc = (f32x4){1.f, 1.f, 1.f, 1.f};
        GS8_DMA(n0, 0);
        const bf16* vtp = B.VT + ((size_t)(h * GLA_NCH) * 512 * 64) + (size_t)slice * 1024 + lane * 8;
        bf16x8 vn0 = *(const bf16x8*)(vtp + (size_t)n0 * 512 * 64), vn1 = *(const bf16x8*)(vtp + (size_t)n0 * 512 * 64 + 512);
        asm volatile("s_waitcnt vmcnt(0)" ::: "memory");
        GS_BAR();
#pragma unroll 1
        for (int n = n0; n < n1; ++n) {
            const int bsel = (n - n0) & 1;
            GS8_DMA(n + 1, bsel ^ 1);
            const LAS unsigned char* bp = F.lds + bsel * GS2_BUF;
            const bf16x8 v0 = vn0, v1 = vn1;
            { const int nn = n + 1 < n1 ? n + 1 : n; vn0 = *(const bf16x8*)(vtp + (size_t)nn * 512 * 64); vn1 = *(const bf16x8*)(vtp + (size_t)nn * 512 * 64 + 512); }
            bf16x8 Sb[8];
#pragma unroll
            for (int s = 0; s < 8; ++s) { v4u wv; wv.x = pk2(S[2 * s].x, S[2 * s].y); wv.y = pk2(S[2 * s].z, S[2 * s].w); wv.z = pk2(S[2 * s + 1].x, S[2 * s + 1].y); wv.w = pk2(S[2 * s + 1].z, S[2 * s + 1].w); Sb[s] = __builtin_bit_cast(bf16x8, wv); }
            f32x4 oacc[4];
#pragma unroll
            for (int m = 0; m < 4; ++m) oacc[m] = (f32x4){0.f, 0.f, 0.f, 0.f};
#define GS_SB() __builtin_amdgcn_sched_barrier(0)
#define GS_LQ(R, s0) do { _Pragma("unroll") for (int m = 0; m < 4; ++m) R[m] = *(const LAS bf16x8*)(bp + GS2_QI + qrd + m * 8448 + (s0) * 64); } while (0)
#define GS_MM(R, s0) do { _Pragma("unroll") for (int m = 0; m < 4; ++m) oacc[m] = __builtin_amdgcn_mfma_f32_16x16x32_bf16(Sb[(s0)], R[m], oacc[m], 0, 0, 0); } while (0)
            {   bf16x8 qa[4], qb[4], qc[4];
                GS_LQ(qa, 0); GS_LQ(qb, 1); GS_LQ(qc, 2); GS_SB();
                GS_MM(qa, 0); GS_SB(); GS_LQ(qa, 3); GS_SB();
                GS_MM(qb, 1); GS_SB(); GS_LQ(qb, 4); GS_SB();
                GS_MM(qc, 2); GS_SB(); GS_LQ(qc, 5); GS_SB();
                GS_MM(qa, 3); GS_SB(); GS_LQ(qa, 6); GS_SB();
                GS_MM(qb, 4); GS_SB(); GS_LQ(qb, 7); GS_SB();
                GS_MM(qc, 5); GS_SB();
                GS_MM(qa, 6); GS_MM(qb, 7); GS_SB(); }
#pragma unroll
            for (int m = 0; m < 4; ++m) { v2u ov; ov.x = pk2(oacc[m].x, oacc[m].y); ov.y = pk2(oacc[m].z, oacc[m].w); *(v2u*)(B.OI + ((((((size_t)(n * GLA_H + h) * 8 + (slice >> 2)) * 4 + m) * 2 + ((slice & 3) >> 1)) * 64 + (2 * (slice & 1) + (fq >> 1)) * 16 + fr) * 8 + 4 * (fq & 1))) = ov; }
#define GS_LK(R, D_, i0) do { _Pragma("unroll") for (int ii = 0; ii < 2; ++ii) { D_[ii] = *(const LAS f32x4*)(bp + GS2_DL + (16 * ((i0) + ii) + 4 * fq) * 4); \
                R[2 * ii] = *(const LAS bf16x8*)(bp + GS2_KET + krd + ((i0) + ii) * 2176); R[2 * ii + 1] = *(const LAS bf16x8*)(bp + GS2_KET + krd + ((i0) + ii) * 2176 + 64); } } while (0)
#define GS_UP(R, D_, i0) do { _Pragma("unroll") for (int ii = 0; ii < 2; ++ii) { S[(i0) + ii] = S[(i0) + ii] * D_[ii]; \
                S[(i0) + ii] = __builtin_amdgcn_mfma_f32_16x16x32_bf16(R[2 * ii], v0, S[(i0) + ii], 0, 0, 0); S[(i0) + ii] = __builtin_amdgcn_mfma_f32_16x16x32_bf16(R[2 * ii + 1], v1, S[(i0) + ii], 0, 0, 0); } } while (0)
            {   bf16x8 ka[4], kb[4], kc[4]; f32x4 da[2], db[2], dc[2];
                GS_LK(ka, da, 0); GS_LK(kb, db, 2); GS_LK(kc, dc, 4); GS_SB();
                GS_UP(ka, da, 0); GS_SB(); GS_LK(ka, da, 6); GS_SB();
                GS_UP(kb, db, 2); GS_SB(); GS_LK(kb, db, 8); GS_SB();
                GS_UP(kc, dc, 4); GS_SB(); GS_LK(kc, dc, 10); GS_SB();
                GS_UP(ka, da, 6); GS_SB(); GS_LK(ka, da, 12); GS_SB();
                GS_UP(kb, db, 8); GS_SB(); GS_LK(kb, db, 14); GS_SB();
                GS_UP(kc, dc, 10); GS_SB();
                GS_UP(ka, da, 12); GS_UP(kb, db, 14); GS_SB(); }
            if (wid == 0) pacc = pacc * *(const LAS f32x4*)(bp + GS2_DL + lane * 16);
#undef GS_LK
#undef GS_UP
#undef GS_SB
#undef GS_LQ
#undef GS_MM
            asm volatile("s_waitcnt vmcnt(0)" ::: "memory");
            GS_BAR();
        }
        {   float* se = B.SE + ((size_t)((g * GLA_H + h) * 32 + slice) * 16 * 64 + lane) * 4;
#pragma unroll
            for (int i = 0; i < 16; ++i) *(f32x4*)(se + (size_t)i * 256) = S[i]; }
        if ((unit & 3) == 0 && wid == 0) *(f32x4*)(B.PE + (size_t)(g * GLA_H + h) * 256 + lane * 4) = pacc;
#undef GS8_DMA
#undef GS_BAR
    }
}
__device__ __forceinline__ void gla_fold(Frame& F, const GlaBufs& B) {
    const int lane = F.lane, fr = lane & 15, fq = lane >> 4;
    const int wu = F.vcu + F.G * F.wave;
    if (wu < GLA_H * 32 * 4) {
        const int h = wu >> 7, slice = (wu >> 2) & 31, quad = wu & 3;
        f32x4 S[4], P[3][4], E[3][4];
#pragma unroll
        for (int j = 0; j < 4; ++j) S[j] = (f32x4){0.f, 0.f, 0.f, 0.f};
#define GF_LOAD(r_, gp_) do { const float* pe = B.PE + (size_t)((gp_) * GLA_H + h) * 256 + 4 * fq + 64 * quad; const float* se = B.SE + ((size_t)(((gp_) * GLA_H + h) * 32 + slice) * 16 * 64 + lane) * 4 + (size_t)quad * 1024; \
            _Pragma("unroll") for (int j = 0; j < 4; ++j) { P[r_][j] = *(const f32x4*)(pe + 16 * j); E[r_][j] = *(const f32x4*)(se + (size_t)j * 256); } } while (0)
        GF_LOAD(0, 0); GF_LOAD(1, 1); GF_LOAD(2, 2);
#pragma unroll
        for (int gp = 0; gp < GLA_G - 1; ++gp) {
#pragma unroll
            for (int j = 0; j < 4; ++j) S[j] = S[j] * P[gp % 3][j] + E[gp % 3][j];
            if (gp + 3 < GLA_G - 1) GF_LOAD(gp % 3, gp + 3);
            const int dv_ = slice * 16 + fr, wv_ = dv_ >> 6, r5_ = dv_ & 31, nn_ = 2 * ((dv_ >> 5) & 1) + ((r5_ >> 2) & 1), fo_ = 4 * (r5_ >> 3) + (r5_ & 3);
            bf16* so = B.S0T + (size_t)(gp * GLA_H + h) * 512 * 256 + ((size_t)((wv_ * 4 + nn_) * 8 + 2 * quad) * 64 + fq * 16 + fo_) * 8;
#pragma unroll
            for (int s2 = 0; s2 < 2; ++s2) { v4u wv; wv.x = pk2(S[2 * s2].x, S[2 * s2].y); wv.y = pk2(S[2 * s2].z, S[2 * s2].w); wv.z = pk2(S[2 * s2 + 1].x, S[2 * s2 + 1].y); wv.w = pk2(S[2 * s2 + 1].z, S[2 * s2 + 1].w);
                *(v4u*)(so + 512 * s2) = wv; }
        }
#undef GF_LOAD
    } else if (wu < GLA_H * 32 * 4 + GLA_H * (GLA_G - 1)) {
        const int u = wu - GLA_H * 32 * 4, h = u / (GLA_G - 1), g = 1 + u % (GLA_G - 1);
        const int c0 = 32 * (lane >> 3) + 16 * (lane & 1) + 4 * ((lane >> 1) & 3);
        f32x4 dl[GLA_GC];
#pragma unroll
        for (int i = 0; i < GLA_GC; ++i) dl[i] = *(const f32x4*)(B.DL + (size_t)(h * GLA_NCH + g * GLA_GC + i) * 256 + c0);
        f32x4 d = (f32x4){1.f, 1.f, 1.f, 1.f};
#pragma unroll
        for (int i = 0; i < GLA_GC; ++i) { *(f32x4*)(B.DPOS + (size_t)(h * GLA_NCH + g * GLA_GC + i) * 256 + 4 * lane) = d; d = d * dl[i]; }
    }
}
__device__ __forceinline__ void gla_out(Frame& F, const bf16* GATE, const float* norm_g, const GlaBufs& B, bf16* OG) {
    LAS bf16* As = (LAS bf16*)(F.lds);
    LAS float* part = (LAS float*)(F.lds + 16384);
    LAS unsigned char* QIs = F.lds + 20480;
    LAS float* DPs = (LAS float*)(F.lds + 20480 + 64 * 528);
    LAS unsigned char* QTs = F.lds + 55296, *KTs = F.lds + 55296 + 64 * 528;
    const int wid = F.wave;
    const bool paired = F.G * 2 == GLA_NCH * GLA_H;
    for (int ui = F.vcu; ui < GLA_NCH * GLA_H; ui += F.G) {
        const int unit = paired ? ((F.vcu >> 2) * 2 + (ui >= F.G ? 1 : 0)) * 4 + (F.vcu & 3) : ui;
        const int n = unit >> 2, h = unit & 3, t0 = n * GLA_C;
        __syncthreads();
        int tdl = F.tid; asm volatile("" : "+v"(tdl));
        const int lane = tdl & 63, fr = lane & 15, fq = lane >> 4;
        const bool corr = n >= GLA_GC;
        v4u qst[4], qtt[4], ktt[4];
#pragma unroll
        for (int i = 0; i < 4; ++i) { const int id = tdl + 512 * i; const size_t go = (size_t)(t0 + (id >> 5)) * 1024 + h * 256 + (id & 31) * 8;
            qtt[i] = *(const v4u*)(B.QT + go); ktt[i] = *(const v4u*)(B.KT + go); qst[i] = *(const v4u*)(B.QI + go); }
        const f32x4 dst_ = *(const f32x4*)(B.DPOS + (size_t)(h * GLA_NCH + n) * 256 + 4 * (tdl & 63));
        v4u oi_[4][2];
#pragma unroll
        for (int m = 0; m < 4; ++m)
#pragma unroll
            for (int np = 0; np < 2; ++np) oi_[m][np] = *(const v4u*)(B.OI + ((((((size_t)(n * GLA_H + h) * 8 + wid) * 4 + m) * 2 + np) * 64 + lane) * 8));
        __builtin_amdgcn_sched_barrier(0);
        const __amdgpu_buffer_rsrc_t s0rs = __builtin_amdgcn_make_buffer_rsrc((void*)(B.S0T + (size_t)((corr ? n / GLA_GC - 1 : 0) * GLA_H + h) * 512 * 256), 0, 512 * 256 * 2, 0x00020000);
        const int s0vo = lane * 16;
        bf16x8 sf[4][4];
        if (corr) {
#pragma unroll
            for (int s4 = 0; s4 < 4; ++s4)
#pragma unroll
                for (int nn = 0; nn < 4; ++nn) sf[s4][nn] = __builtin_bit_cast(bf16x8, __builtin_amdgcn_raw_buffer_load_b128(s0rs, s0vo, ((wid * 4 + nn) * 8 + s4) * 1024, 0));
        }
        bf16x8 vf[2][4]; v4u rr_[4][2]; f32x4 g4_[2][2];
#pragma unroll
        for (int s = 0; s < 2; ++s)
#pragma unroll
            for (int nn = 0; nn < 4; ++nn) vf[s][nn] = *(const bf16x8*)(B.VT + (size_t)(h * GLA_NCH + n) * 512 * 64 + ((size_t)((4 * wid + 2 * (nn >> 1) + (fr >> 3)) * 2 + s) * 64 + fq * 16 + 8 * ((fr >> 2) & 1) + 4 * (nn & 1) + (fr & 3)) * 8);
        __builtin_amdgcn_sched_barrier(0);
#pragma unroll
        for (int i = 0; i < 4; ++i) { const int id = tdl + 512 * i; const int lo_ = (id >> 5) * 528 + (id & 31) * 16;
            *(LAS v4u*)(QTs + lo_) = qtt[i]; *(LAS v4u*)(KTs + lo_) = ktt[i]; *(LAS v4u*)(QIs + lo_) = qst[i]; }
        if (tdl < 64) *(LAS f32x4*)(DPs + tdl * 4) = dst_;
        __syncthreads();
        {
            const int mt = wid >> 1;
            f32x4 a2[2] = {(f32x4){0.f, 0.f, 0.f, 0.f}, (f32x4){0.f, 0.f, 0.f, 0.f}};
#pragma unroll
            for (int s = 0; s < 8; ++s) { const bf16x8 qf = *(const LAS bf16x8*)(QTs + (16 * mt + fr) * 528 + s * 64 + fq * 16);
#pragma unroll
                for (int j = 0; j < 2; ++j) { const int nt = 2 * (wid & 1) + j; const bf16x8 kf = *(const LAS bf16x8*)(KTs + (16 * nt + fr) * 528 + s * 64 + fq * 16);
                    a2[j] = __builtin_amdgcn_mfma_f32_16x16x32_bf16(qf, kf, a2[j], 0, 0, 0); } }
#pragma unroll
            for (int j = 0; j < 2; ++j) { const int nt = 2 * (wid & 1) + j, col = 16 * nt + fr;
#pragma unroll
                for (int r = 0; r < 4; ++r) { const int row = 16 * mt + 4 * fq + r; As[row * 72 + col] = (bf16)f2bf(col <= row ? a2[j][r] : 0.f); } }
        }
        __syncthreads();
        f32x4 acc[4][4];
#pragma unroll
        for (int m = 0; m < 4; ++m)
#pragma unroll
            for (int np = 0; np < 2; ++np) { const v4u a_ = oi_[m][np];
                acc[m][2 * np] = (f32x4){bflo(a_.x), bfhi(a_.x), bflo(a_.y), bfhi(a_.y)}; acc[m][2 * np + 1] = (f32x4){bflo(a_.z), bfhi(a_.z), bflo(a_.w), bfhi(a_.w)}; }
#define GO_CORR(s0_) do { _Pragma("unroll") for (int s4 = 0; s4 < 4; ++s4) { const int sb_ = (s0_) + s4; \
            const f32x4 d0_ = *(const LAS f32x4*)(DPs + 32 * sb_ + 8 * fq), d1_ = *(const LAS f32x4*)(DPs + 32 * sb_ + 8 * fq + 4); \
            _Pragma("unroll") for (int m = 0; m < 4; ++m) { const v4u q_ = *(const LAS v4u*)(QIs + (16 * m + fr) * 528 + sb_ * 64 + fq * 16); v4u w_; \
                w_.x = pk2(bflo(q_.x) * d0_.x, bfhi(q_.x) * d0_.y); w_.y = pk2(bflo(q_.y) * d0_.z, bfhi(q_.y) * d0_.w); w_.z = pk2(bflo(q_.z) * d1_.x, bfhi(q_.z) * d1_.y); w_.w = pk2(bflo(q_.w) * d1_.z, bfhi(q_.w) * d1_.w); \
                const bf16x8 qs_ = __builtin_bit_cast(bf16x8, w_); \
                _Pragma("unroll") for (int nn = 0; nn < 4; ++nn) acc[m][nn] = __builtin_amdgcn_mfma_f32_16x16x32_bf16(sf[s4][nn], qs_, acc[m][nn], 0, 0, 0); } \
            __builtin_amdgcn_sched_barrier(0); } } while (0)
        if (corr) {
            GO_CORR(0);
#pragma unroll
            for (int s4 = 0; s4 < 4; ++s4)
#pragma unroll
                for (int nn = 0; nn < 4; ++nn) sf[s4][nn] = __builtin_bit_cast(bf16x8, __builtin_amdgcn_raw_buffer_load_b128(s0rs, s0vo, ((wid * 4 + nn) * 8 + 4 + s4) * 1024, 0));
            __builtin_amdgcn_sched_barrier(0);
        }
#pragma unroll
        for (int s = 0; s < 2; ++s) {
            bf16x8 af[4];
#pragma unroll
            for (int m = 0; m < 4; ++m) af[m] = *(const LAS bf16x8*)(As + (16 * m + fr) * 72 + 32 * s + 8 * fq);
#pragma unroll
            for (int m = 0; m < 4; ++m)
#pragma unroll
                for (int nn = 0; nn < 4; ++nn) acc[m][nn] = __builtin_amdgcn_mfma_f32_16x16x32_bf16(vf[s][nn], af[m], acc[m][nn], 0, 0, 0);
        }
        __builtin_amdgcn_sched_barrier(0);
#pragma unroll
        for (int np = 0; np < 2; ++np) { const int dv = 64 * wid + 32 * np + 8 * fq; g4_[np][0] = *(const f32x4*)(norm_g + dv); g4_[np][1] = *(const f32x4*)(norm_g + dv + 4);
#pragma unroll
            for (int m = 0; m < 4; ++m) rr_[m][np] = *(const v4u*)(GATE + ((((((size_t)(n * GLA_H + h) * 8 + wid) * 4 + m) * 2 + np) * 64 + lane) * 8)); }
        __builtin_amdgcn_sched_barrier(0);
        if (corr) GO_CORR(4);
#undef GO_CORR
#pragma unroll
        for (int m = 0; m < 4; ++m) { float ss = 0.f;
#pragma unroll
            for (int nn = 0; nn < 4; ++nn) ss += (acc[m][nn].x * acc[m][nn].x + acc[m][nn].y * acc[m][nn].y) + (acc[m][nn].z * acc[m][nn].z + acc[m][nn].w * acc[m][nn].w);
            ss += __shfl_xor(ss, 16); ss += __shfl_xor(ss, 32);
            if (fq == 0) part[wid * 64 + 16 * m + fr] = ss; }
        __syncthreads();
#pragma unroll
        for (int m = 0; m < 4; ++m) { float tot = 0.f;
#pragma unroll
            for (int w8 = 0; w8 < 8; ++w8) tot += part[w8 * 64 + 16 * m + fr];
            const float rs = 1.f / sqrtf(tot * (1.f / 512.f) + RMS_EPS);
            const size_t ro = (size_t)(t0 + 16 * m + fr);
#pragma unroll
            for (int np = 0; np < 2; ++np) { const int dv = 64 * wid + 32 * np + 8 * fq;
                const v4u rr = rr_[m][np];
                const f32x4 o0 = acc[m][2 * np] * rs * g4_[np][0], o1 = acc[m][2 * np + 1] * rs * g4_[np][1]; v4u ov;
                ov.x = pk2(o0.x * silu(bflo(rr.x)), o0.y * silu(bfhi(rr.x))); ov.y = pk2(o0.z * silu(bflo(rr.y)), o0.w * silu(bfhi(rr.y)));
                ov.z = pk2(o1.x * silu(bflo(rr.z)), o1.y * silu(bfhi(rr.z))); ov.w = pk2(o1.z * silu(bflo(rr.w)), o1.w * silu(bfhi(rr.w)));
                *(v4u*)(OG + ro * DM + h * 512 + dv) = ov; } }
    }
}

constexpr int NPHASE = 18;
struct Args { const float* in[20]; float* out; unsigned char* ws; int ph_lo, ph_hi; };
__global__ void __launch_bounds__(NTHR, 2) mk_fwd(Args args) {
    extern __shared__ __attribute__((aligned(16))) unsigned char lds[];
    Frame F;
    F.lds = (LAS unsigned char*)lds;
    F.tid = threadIdx.x; F.lane = F.tid & 63; F.wave = __builtin_amdgcn_readfirstlane(F.tid >> 6);
    F.G = gridDim.x; { const int bx = blockIdx.x; F.vcu = (F.G % 8 == 0) ? (bx % 8) * (F.G / 8) + bx / 8 : bx; }
    unsigned char* ws = args.ws;
    F.ctl = (unsigned*)(ws + WS_CTL);
    volatile LAS unsigned* MISC = (volatile LAS unsigned*)(F.lds + MISC_OFF);
    if (F.tid < 16) MISC[F.tid] = 0u;
    __syncthreads();
    const int lo = args.ph_lo, hi = args.ph_hi;
    XcdBarrier bar; bar.bar = F.ctl + CW_BAR; bar.x = 0; bar.st = MISC;
    if (hi - lo > 1) bar = xcd_barrier_post(F.ctl + CW_BAR, MISC);
#define IN(k) (lo <= (k) && (k) < hi)
#define RUN(k) if (IN(k)) for (int rep_ = 0; rep_ < 1 + (int)((DBL_MASK >> (k)) & 1u); ++rep_, __syncthreads())
#define SEAM(k) do { if (IN(k) && IN((k) + 1)) xcd_barrier(bar); } while (0)
    const float* x = args.in[0];
    bf16* XB = (bf16*)(ws + WS_XB); bf16* QKV = (bf16*)(ws + WS_QKV); float* FLOG = (float*)(ws + WS_FLOG); float* CB = (float*)(ws + WS_CB);
    bf16* O = (bf16*)(ws + WS_O); bf16* Y = (bf16*)(ws + WS_Y);
    int* TOPE = (int*)(ws + WS_TOPE); float* TOPG = (float*)(ws + WS_TOPG); int* LIST = (int*)(ws + WS_LIST); bf16* YE = (bf16*)(ws + WS_YE); bf16* HID = (bf16*)(ws + WS_HID);
    float* WR = (float*)(ws + WS_WR); float* WGL = (float*)(ws + WS_WGL);
    const size_t MOEW = (size_t)NEXP * DM * EFF;
    const GlaBufs GB{(bf16*)(ws + WS_GQT), (bf16*)(ws + WS_GKT), (bf16*)(ws + WS_GQI), (bf16*)(ws + WS_GKET), (bf16*)(ws + WS_GVT), (float*)(ws + WS_GDL), (bf16*)(ws + WS_GOI),
                     (float*)(ws + WS_GOI2 + 24 * MiB), (float*)(ws + WS_GPE), (bf16*)(ws + WS_GOI2), (bf16*)(ws + WS_GOI2), (float*)(ws + WS_GOI2 + 16 * MiB)};

    RUN(0) {
        P0Args a{x, args.in[1], args.in[3], args.in[4], args.in[8], args.in[13], args.in[15],
                 (bf16*)(ws + WT_FOX_IN), (bf16*)(ws + WT_FOX_O), (bf16*)(ws + WT_GLA_IN), (bf16*)(ws + WT_GLA_O), WR, WGL, XB, FLOG, (void*)(ws + WS_WF)};
        p0_prologue(F, a);
    }
    SEAM(0);
    RUN(1) {
        if ((int)blockIdx.x < FOX_H) fox_cumsum(F, FLOG, args.in[2], CB, (int)blockIdx.x);
        pg8::Gemm g{XB, (const bf16*)(ws + WT_FOX_IN), T, NQKV, DM}; pg8::StaticOrder S; S.init(T, NQKV, F.G, (int)blockIdx.x);
        pg8::EpiQKVH E{QKV, T};
        pg8::gemm_phase<pg8::EpiQKVH, pg8::StaticOrder, true, true>(F.lds + RING_OFF, g, S, E);
    }
    SEAM(1);
    RUN(2) { fox::phase((char*)lds + RING_OFF, QKV, CB, O, F.vcu, F.G); }
    SEAM(2);
    RUN(3) {
        pg8::Gemm g{O, (const bf16*)(ws + WT_FOX_O), T, DM, DM}; pg8::StaticOrder S; S.init(T, DM, F.G, (int)blockIdx.x);
        pg8::EpiBf16<0> E{Y, DM, nullptr, 0, 0, 1.f};
        pg8::gemm_phase<pg8::EpiBf16<0>, pg8::StaticOrder, true, true>(F.lds + RING_OFF, g, S, E);
    }
    SEAM(3);
    RUN(4) {
        LnArgs A{Y, XB, nullptr, 2, args.in[9], args.in[10], nullptr, XB, (const float*)(ws + WS_WF), args.in[14], args.in[16], TOPE, TOPG, rep_ == 0 ? F.ctl + CW_CNT : nullptr, LIST, nullptr};
        ln_phase<9, 2>(F, A);
    }
    SEAM(4);
#ifndef MOE_VAR
#define MOE_VAR 0
#endif
    RUN(5) { MoeArgs A{F.ctl + CW_CNT, LIST, TOPG, XB, args.in[17], args.in[18], args.in[19], HID, YE, rep_ == 0 ? F.ctl + CW_MOEF : nullptr}; moe_phase<0>(F, A); }
    if (MOE_VAR != 0 && IN(5)) { __syncthreads(); MoeArgs A{F.ctl + CW_CNT, LIST, TOPG, XB, args.in[17], args.in[18], args.in[19], (bf16*)(ws + WS_END), (bf16*)(ws + WS_END)}; moe_phase<0, MOE_VAR>(F, A); }
    RUN(6) { MoeArgs A{F.ctl + CW_CNT, LIST, TOPG, XB, args.in[17], args.in[18], args.in[19], HID, YE, F.ctl + CW_MOEF}; moe_phase<1>(F, A); }
    SEAM(6);
    RUN(7) {
        LnArgs A{nullptr, XB, YE, 1, args.in[11], args.in[12], nullptr, XB, (const float*)(ws + WS_WF + (size_t)2 * 2 * 128 * 3 * 512 * 2), nullptr, nullptr, nullptr, nullptr, nullptr, nullptr, FLOG};
        ln_phase<2, 1>(F, A);
    }
    SEAM(7);
    RUN(8) {
        pg8::Gemm g{XB, (const bf16*)(ws + WT_GLA_IN), T, NQKV, DM}; pg8::StaticOrder S; S.init(T, NQKV, F.G, (int)blockIdx.x);
        pg8::EpiGla E{QKV, NQKV, (bf16*)(ws + WS_GATE)};
        pg8::gemm_phase<pg8::EpiGla, pg8::StaticOrder, true, true>(F.lds + RING_OFF, g, S, E);
    }
    SEAM(8);
    RUN(9) gla_prep(F, QKV, FLOG, args.in[5], args.in[6], GB);
    SEAM(9);
    RUN(10) gla_scan8(F, GB);
    SEAM(10);
    RUN(11) gla_fold(F, GB);
    SEAM(11);
    RUN(12) gla_out(F, (const bf16*)(ws + WS_GATE), args.in[7], GB, O);
    SEAM(12);
    RUN(13) {
        pg8::Gemm g{O, (const bf16*)(ws + WT_GLA_O), T, DM, DM}; pg8::StaticOrder S; S.init(T, DM, F.G, (int)blockIdx.x);
        pg8::EpiBf16<0> E{Y, DM, nullptr, 0, 0, 1.f};
        pg8::gemm_phase<pg8::EpiBf16<0>, pg8::StaticOrder, true, true>(F.lds + RING_OFF, g, S, E);
    }
    SEAM(13);
    RUN(14) {
        LnArgs A{Y, XB, nullptr, 2, args.in[9] + DM, args.in[10] + DM, nullptr, XB, (const float*)(ws + WS_WF + (size_t)2 * 128 * 3 * 512 * 2), args.in[14] + 8, args.in[16] + 64, TOPE, TOPG, F.ctl + CW_CNT + 64, LIST, nullptr};
        ln_phase<9, 2>(F, A);
    }
    SEAM(14);
    RUN(15) { MoeArgs A{F.ctl + CW_CNT + 64, LIST, TOPG, XB, args.in[17] + MOEW, args.in[18] + MOEW, args.in[19] + MOEW, HID, YE, rep_ == 0 ? F.ctl + CW_MOEF + 64 * 64 : nullptr}; moe_phase<0>(F, A); }
    RUN(16) { MoeArgs A{F.ctl + CW_CNT + 64, LIST, TOPG, XB, args.in[17] + MOEW, args.in[18] + MOEW, args.in[19] + MOEW, HID, YE, F.ctl + CW_MOEF + 64 * 64}; moe_phase<1>(F, A); }
    SEAM(16);
    RUN(17) {
        LnArgs A{nullptr, XB, YE, 1, args.in[11] + DM, args.in[12] + DM, args.out, nullptr, nullptr, nullptr, nullptr, nullptr, nullptr, nullptr, nullptr, nullptr};
        ln_phase<0, 1>(F, A);
    }
#ifdef PROBE_MAXCNT
    if (blockIdx.x == 0 && F.tid == 0) { unsigned mx = 0, mn = 1u << 30; for (int i = 0; i < 128; ++i) { const unsigned c = F.ctl[CW_CNT + i]; mx = c > mx ? c : mx; mn = c < mn ? c : mn; }
        if (mx > PROBE_MAXCNT || mn < PROBE_MINCNT) args.out[0] = __builtin_nanf(""); }
#endif
#ifdef EXTRA_BARS
    if (hi - lo > 1) for (int i = 0; i < EXTRA_BARS; ++i) xcd_barrier(bar);
#endif
#undef IN
#undef RUN
#undef SEAM
}

extern "C" void kernel_launch(void* const* d_in, const int* in_sizes, int n_in, void* d_out, int out_size, void* d_ws, size_t ws_size, hipStream_t stream) {
    if (n_in != 20 || in_sizes[0] != T * DM || out_size != T * DM || ws_size < WS_END) { fprintf(stderr, "kernel_launch: unexpected shapes n_in %d in0 %d out %d ws %zu\n", n_in, n_in > 0 ? in_sizes[0] : -1, out_size, ws_size); return; }
    unsigned char* ws = (unsigned char*)d_ws;
    static int grid = 0;
    if (grid == 0) {
        int dev = 0, cus = 0, per_cu = 0;
        if (hipGetDevice(&dev) != hipSuccess || hipDeviceGetAttribute(&cus, hipDeviceAttributeMultiprocessorCount, dev) != hipSuccess) { fprintf(stderr, "kernel_launch: device query failed\n"); grid = -1; return; }
        if (hipFuncSetAttribute((const void*)mk_fwd, hipFuncAttributeMaxDynamicSharedMemorySize, LDS_BYTES) != hipSuccess) { fprintf(stderr, "kernel_launch: hipFuncSetAttribute failed\n"); grid = -1; return; }
        if (hipOccupancyMaxActiveBlocksPerMultiprocessor(&per_cu, (const void*)mk_fwd, NTHR, LDS_BYTES) != hipSuccess || per_cu < 1) fprintf(stderr, "kernel_launch: occupancy query says %d per CU\n", per_cu);
        (void)hipGetLastError();
        grid = cus;
    }
    if (grid < 0) return;
    (void)hipMemsetAsync(ws + WS_CTL, 0, CTL_ZERO_BYTES, stream);
    Args a{};
    for (int i = 0; i < 20; ++i) a.in[i] = (const float*)d_in[i];
    a.out = (float*)d_out; a.ws = ws; a.ph_lo = 0; a.ph_hi = NPHASE;
    hipLaunchKernelGGL(mk_fwd, dim3(grid), dim3(NTHR), LDS_BYTES, stream, a);
}
```
